# Optimizing an MI355X kernel written in HIP

```python
import math
import jax, jax.numpy as jnp
from jax import lax
import numpy as np

D_MODEL = 1024
BATCH = 2
SEQ = 16384
DEPTH = 4

N_MIXERS = 2
N_LAYERS_A = (DEPTH + N_MIXERS - 1) // N_MIXERS
N_LAYERS_B = DEPTH // N_MIXERS
N_META = 16
D_RNN = D_MODEL
N_LRU_BLOCKS = 4
LRU_BLOCK = D_RNN // N_LRU_BLOCKS
CONV_WIDTH = 4
LRU_C = 8.0
HEAD_DIM = 64
N_Q_HEADS = D_MODEL // HEAD_DIM
N_KV_HEADS = 4
Q_PER_KV = N_Q_HEADS // N_KV_HEADS
WINDOW = 128
QKV_WIDTH = (N_Q_HEADS + 2 * N_KV_HEADS) * HEAD_DIM
N_BUCKETS = 32
MAX_EXACT = N_BUCKETS // 2
MAX_DISTANCE = WINDOW
N_EXPERTS = 64
TOP_K = 8
N_GROUPS = 8
TOPK_GROUPS = 4
D_EXPERT = 256
D_SHARED = 256
ROUTED_SCALE = 2.5
EXPERT_BLOCK = 256
ALPHA = (2 * DEPTH) ** 0.25
BETA = (8 * DEPTH) ** -0.25
LN_EPS = 1e-5

kernel_name = "hybrid_rglru_swa_sink_moe_deepnorm"


def _layer_norm(z, g, b):
    zf = z.astype(jnp.float32)
    mu = jnp.mean(zf, axis=-1, keepdims=True)
    var = jnp.mean(jnp.square(zf - mu), axis=-1, keepdims=True)
    out = (zf - mu) * lax.rsqrt(var + LN_EPS) * g.astype(jnp.float32) + b.astype(jnp.float32)
    return out.astype(z.dtype)


def _linear_combine(c1, c2):
    a1, b1 = c1
    a2, b2 = c2
    return a1 * a2, a2 * b1 + b2


def _rglru_mixer(h, w_in, b_in, conv_w, conv_b, w_gates, b_gates, a_param, w_out):
    B, L, _ = h.shape
    u = h @ w_in + b_in
    y = jax.nn.gelu(u[..., :D_RNN], approximate=True)
    xr = u[..., D_RNN:]
    xp = jnp.pad(xr, ((0, 0), (CONV_WIDTH - 1, 0), (0, 0)))
    xc = conv_b + xp[:, 0:L] * conv_w[0]
    for k in range(1, CONV_WIDTH):
        xc = xc + xp[:, k:k + L] * conv_w[k]
    g = jnp.einsum('blnc,ncd->blnd', xc.reshape(B, L, N_LRU_BLOCKS, LRU_BLOCK), w_gates) + b_gates
    gate_x = jax.nn.sigmoid(g[..., :LRU_BLOCK].astype(jnp.float32)).reshape(B, L, D_RNN)
    gate_a = jax.nn.sigmoid(g[..., LRU_BLOCK:].astype(jnp.float32)).reshape(B, L, D_RNN)
    log_a = -LRU_C * gate_a * jax.nn.softplus(-a_param.astype(jnp.float32))
    a = jnp.exp(log_a)
    mult = jnp.sqrt(-jnp.expm1(2.0 * log_a))
    bx = xc.astype(jnp.float32) * gate_x * mult
    _, hs = lax.associative_scan(_linear_combine, (a, bx), axis=1)
    return (y * hs.astype(h.dtype)) @ w_out


def _t5_bucket(d):
    d = jnp.maximum(d, 0)
    df = jnp.maximum(d, 1).astype(jnp.float32)
    large = MAX_EXACT + (jnp.log(df / MAX_EXACT) / math.log(MAX_DISTANCE / MAX_EXACT)
                         * (N_BUCKETS - MAX_EXACT)).astype(jnp.int32)
    large = jnp.minimum(large, N_BUCKETS - 1)
    return jnp.where(d < MAX_EXACT, d, large)


def _rel_bias(rel_table, d):
    b = rel_table[_t5_bucket(d)]
    return jnp.moveaxis(b, -1, 0).reshape(N_KV_HEADS, Q_PER_KV, *d.shape).astype(jnp.float32)


def _sink_attend(s, mask, sinks_hg, v):
    s = jnp.where(mask, s, -jnp.inf)
    sink = sinks_hg[None, :, :, None, None]
    m = jnp.maximum(jnp.max(s, axis=-1, keepdims=True), sink)
    p = jnp.exp(s - m)
    denom = jnp.sum(p, axis=-1, keepdims=True) + jnp.exp(sink - m)
    return jnp.einsum('bhgqk,bkhd->bqhgd', (p / denom).astype(v.dtype), v)


def _swa_mixer(h, w_qkv, sinks, w_o, rel_table):
    B, L, _ = h.shape
    n_blocks = (L - N_META) // WINDOW
    qkv = h @ w_qkv
    q = (qkv[..., :N_Q_HEADS * HEAD_DIM] * HEAD_DIM ** -0.5).reshape(B, L, N_KV_HEADS, Q_PER_KV, HEAD_DIM)
    k = qkv[..., N_Q_HEADS * HEAD_DIM:(N_Q_HEADS + N_KV_HEADS) * HEAD_DIM].reshape(B, L, N_KV_HEADS, HEAD_DIM)
    v = qkv[..., (N_Q_HEADS + N_KV_HEADS) * HEAD_DIM:].reshape(B, L, N_KV_HEADS, HEAD_DIM)
    sinks_hg = sinks.astype(jnp.float32).reshape(N_KV_HEADS, Q_PER_KV)
    qm, km, vm = q[:, :N_META], k[:, :N_META], v[:, :N_META]
    d_mm = jnp.arange(N_META)[:, None] - jnp.arange(N_META)[None, :]
    s_mm = jnp.einsum('bqhgd,bkhd->bhgqk', qm, km).astype(jnp.float32) + _rel_bias(rel_table, d_mm)
    o_meta = _sink_attend(s_mm, d_mm >= 0, sinks_hg, vm)

    def to_blocks(t):
        return jnp.moveaxis(t[:, N_META:].reshape(B, n_blocks, WINDOW, *t.shape[2:]), 1, 0)

    qb, kb, vb = to_blocks(q), to_blocks(k), to_blocks(v)
    kp = jnp.concatenate([jnp.zeros_like(kb[:1]), kb[:-1]], axis=0)
    vp = jnp.concatenate([jnp.zeros_like(vb[:1]), vb[:-1]], axis=0)
    qi = jnp.arange(WINDOW)[:, None]
    kj = jnp.arange(2 * WINDOW)[None, :]
    d_loc = WINDOW + qi - kj
    in_win = (d_loc >= 0) & (d_loc < WINDOW)
    in_cur = kj >= WINDOW
    m_idx = jnp.arange(N_META)[None, :]
    meta_vis = jnp.ones((WINDOW, N_META), dtype=bool)

    def block(args):
        n, q_n, kp_n, kc_n, vp_n, vc_n = args
        keys = jnp.concatenate([km, kp_n, kc_n], axis=1)
        vals = jnp.concatenate([vm, vp_n, vc_n], axis=1)
        d = jnp.concatenate([N_META + n * WINDOW + qi - m_idx, d_loc], axis=1)
        mask = jnp.concatenate([meta_vis, in_win & ((n > 0) | in_cur)], axis=1)
        s = jnp.einsum('bqhgd,bkhd->bhgqk', q_n, keys).astype(jnp.float32) + _rel_bias(rel_table, d)
        return _sink_attend(s, mask, sinks_hg, vals)

    o_blk = lax.map(block, (jnp.arange(n_blocks), qb, kp, kb, vp, vb))
    o_real = jnp.moveaxis(o_blk, 0, 1).reshape(B, L - N_META, N_Q_HEADS * HEAD_DIM)
    o = jnp.concatenate([o_meta.reshape(B, N_META, N_Q_HEADS * HEAD_DIM), o_real], axis=1)
    return o @ w_o


def _swiglu(x, w_gu, w_down):
    f = w_down.shape[0]
    gu = x @ w_gu
    return (jax.nn.silu(gu[..., :f]) * gu[..., f:]) @ w_down


def _route(xt, router_w, router_bias):
    n = xt.shape[0]
    scores = jax.nn.sigmoid(xt.astype(jnp.float32) @ router_w.astype(jnp.float32))
    choice = scores + router_bias.astype(jnp.float32)
    grp = choice.reshape(n, N_GROUPS, N_EXPERTS // N_GROUPS)
    grp_score = jnp.sum(lax.top_k(grp, 2)[0], axis=-1)
    _, gidx = lax.top_k(grp_score, TOPK_GROUPS)
    gmask = jnp.any(gidx[..., :, None] == jnp.arange(N_GROUPS), axis=-2)
    emask = jnp.repeat(gmask, N_EXPERTS // N_GROUPS, axis=-1)
    _, idx = lax.top_k(jnp.where(emask, choice, -jnp.inf), TOP_K)
    w = jnp.take_along_axis(scores, idx, axis=-1)
    w = w / (jnp.sum(w, axis=-1, keepdims=True) + 1e-20) * ROUTED_SCALE
    return idx, w


def _routed_experts(xt, idx, wts, w_gu, w_down):
    n, d = xt.shape
    n_assign = n * TOP_K
    flat_e = idx.reshape(-1)
    flat_tok = jnp.arange(n_assign, dtype=jnp.int32) // TOP_K
    flat_w = wts.reshape(-1)
    order = jnp.argsort(flat_e)
    sorted_e = flat_e[order]
    counts = jnp.bincount(flat_e, length=N_EXPERTS)
    padded = (counts + EXPERT_BLOCK - 1) // EXPERT_BLOCK * EXPERT_BLOCK
    start = jnp.cumsum(counts) - counts
    pend = jnp.cumsum(padded)
    pstart = pend - padded
    dest = pstart[sorted_e] + (jnp.arange(n_assign) - start[sorted_e])
    n_blocks = (n_assign + N_EXPERTS * (EXPERT_BLOCK - 1) + EXPERT_BLOCK - 1) // EXPERT_BLOCK
    rows_total = n_blocks * EXPERT_BLOCK
    row_tok = jnp.full((rows_total,), n, dtype=jnp.int32).at[dest].set(flat_tok[order])
    row_w = jnp.zeros((rows_total,), wts.dtype).at[dest].set(flat_w[order])
    block_e = jnp.minimum(jnp.searchsorted(pend, jnp.arange(n_blocks) * EXPERT_BLOCK, side='right'),
                          N_EXPERTS - 1)
    x_pad = jnp.concatenate([xt, jnp.zeros((1, d), xt.dtype)], axis=0)
    f = w_down.shape[1]

    def body(b, acc):
        rows = lax.dynamic_slice(row_tok, (b * EXPERT_BLOCK,), (EXPERT_BLOCK,))
        rw = lax.dynamic_slice(row_w, (b * EXPERT_BLOCK,), (EXPERT_BLOCK,))
        e = block_e[b]
        gu = x_pad[rows] @ w_gu[e]
        y = ((jax.nn.silu(gu[:, :f]) * gu[:, f:]) @ w_down[e]) * rw[:, None]
        return acc.at[rows].add(y)

    acc = lax.fori_loop(0, n_blocks, body, jnp.zeros((n + 1, d), xt.dtype))
    return acc[:n]


def _moe(h, router_w, router_bias, w_gu, w_down, sh_w_gu, sh_w_down):
    B, L, D = h.shape
    xt = h.reshape(B * L, D)
    idx, w = _route(xt, router_w, router_bias)
    routed = _routed_experts(xt, idx, w.astype(xt.dtype), w_gu, w_down)
    shared = _swiglu(xt, sh_w_gu, sh_w_down)
    return (routed + shared).reshape(B, L, D)


def setup_inputs(seed: int = 0) -> dict:
    key = jax.random.key(seed)
    ks = jax.random.split(key, 24)
    f32 = jnp.float32
    nrm = lambda k, s, sc: jax.random.normal(k, s, f32) * sc
    u = jax.random.uniform(ks[8], (N_LAYERS_A, D_RNN), f32, minval=0.9, maxval=0.999)
    s8 = u ** (1.0 / LRU_C)
    a_param = jnp.log(s8) - jnp.log1p(-s8)
    return {
        "x": nrm(ks[0], (BATCH, SEQ, D_MODEL), 1.0),
        "meta_tokens": nrm(ks[1], (N_META, D_MODEL), 1.0),
        "rg_w_in": nrm(ks[2], (N_LAYERS_A, D_MODEL, 2 * D_RNN), D_MODEL ** -0.5),
        "rg_b_in": nrm(ks[3], (N_LAYERS_A, 2 * D_RNN), 0.01),
        "rg_conv_w": nrm(ks[4], (N_LAYERS_A, CONV_WIDTH, D_RNN), CONV_WIDTH ** -0.5),
        "rg_conv_b": nrm(ks[5], (N_LAYERS_A, D_RNN), 0.01),
        "rg_w_gates": nrm(ks[6], (N_LAYERS_A, N_LRU_BLOCKS, LRU_BLOCK, 2 * LRU_BLOCK), LRU_BLOCK ** -0.5),
        "rg_b_gates": nrm(ks[7], (N_LAYERS_A, N_LRU_BLOCKS, 2 * LRU_BLOCK), 0.01),
        "rg_a_param": a_param,
        "rg_w_out": nrm(ks[9], (N_LAYERS_A, D_RNN, D_MODEL), D_RNN ** -0.5 * BETA),
        "attn_w_qkv": nrm(ks[10], (N_LAYERS_B, D_MODEL, QKV_WIDTH), D_MODEL ** -0.5),
        "attn_sinks": nrm(ks[11], (N_LAYERS_B, N_Q_HEADS), 1.0),
        "attn_w_o": nrm(ks[12], (N_LAYERS_B, N_Q_HEADS * HEAD_DIM, D_MODEL), (N_Q_HEADS * HEAD_DIM) ** -0.5 * BETA),
        "rel_bias_table": nrm(ks[13], (N_BUCKETS, N_Q_HEADS), 0.5),
        "ln_gain": 1.0 + nrm(ks[14], (DEPTH, 2, D_MODEL), 0.02),
        "ln_bias": nrm(ks[15], (DEPTH, 2, D_MODEL), 0.02),
        "router_w": nrm(ks[16], (DEPTH, D_MODEL, N_EXPERTS), D_MODEL ** -0.5),
        "router_bias": nrm(ks[17], (DEPTH, N_EXPERTS), 0.01),
        "expert_w_gu": nrm(ks[18], (DEPTH, N_EXPERTS, D_MODEL, 2 * D_EXPERT), D_MODEL ** -0.5),
        "expert_w_down": nrm(ks[19], (DEPTH, N_EXPERTS, D_EXPERT, D_MODEL), D_EXPERT ** -0.5 * BETA),
        "shared_w_gu": nrm(ks[20], (DEPTH, D_MODEL, 2 * D_SHARED), D_MODEL ** -0.5),
        "shared_w_down": nrm(ks[21], (DEPTH, D_SHARED, D_MODEL), D_SHARED ** -0.5 * BETA),
    }


def reference(x, meta_tokens, rg_w_in, rg_b_in, rg_conv_w, rg_conv_b, rg_w_gates, rg_b_gates,
              rg_a_param, rg_w_out, attn_w_qkv, attn_sinks, attn_w_o, rel_bias_table, ln_gain,
              ln_bias, router_w, router_bias, expert_w_gu, expert_w_down, shared_w_gu, shared_w_down):
    B = x.shape[0]
    meta = jnp.broadcast_to(meta_tokens[None].astype(x.dtype), (B, N_META, D_MODEL))
    h = jnp.concatenate([meta, x], axis=1)
    for i in range(DEPTH):
        j = i // N_MIXERS
        if i % N_MIXERS == 0:
            mix = _rglru_mixer(h, rg_w_in[j], rg_b_in[j], rg_conv_w[j], rg_conv_b[j],
                               rg_w_gates[j], rg_b_gates[j], rg_a_param[j], rg_w_out[j])
        else:
            mix = _swa_mixer(h, attn_w_qkv[j], attn_sinks[j], attn_w_o[j], rel_bias_table)
        h = _layer_norm(ALPHA * h + mix, ln_gain[i, 0], ln_bias[i, 0])
        ffn = _moe(h, router_w[i], router_bias[i], expert_w_gu[i], expert_w_down[i],
                   shared_w_gu[i], shared_w_down[i])
        h = _layer_norm(ALPHA * h + ffn, ln_gain[i, 1], ln_bias[i, 1])
    return h[:, N_META:]
```

```cpp
#include <hip/hip_runtime.h>
#include <cstdio>
#include <cstdint>

#ifndef MK_ONE_LAUNCH
#define MK_ONE_LAUNCH 1
#endif

#define DI __device__ __forceinline__
#define LAS __attribute__((address_space(3)))
typedef unsigned short bf16_t;
typedef short bf16x8 __attribute__((ext_vector_type(8)));
typedef float f32x4 __attribute__((ext_vector_type(4)));
typedef float f32x2 __attribute__((ext_vector_type(2)));
typedef float f32x16 __attribute__((ext_vector_type(16)));
typedef unsigned u32x4 __attribute__((ext_vector_type(4)));
typedef unsigned u32x2 __attribute__((ext_vector_type(2)));

constexpr int D = 1024, NBATCH = 2, SEQ = 16384, NMETA = 16;
constexpr int MR = NBATCH * SEQ;
constexpr int NR = MR + NBATCH * NMETA;
constexpr int ZROW = NR;
constexpr int MPAD = 33024;
constexpr int NEXP = 64, TOPK = 8, DE = 256;
constexpr int RT_MAX = 278784;
constexpr int SH_BASE = RT_MAX;
constexpr int ROWS_ALL = RT_MAX + MPAD;
constexpr int N_SH_TILES = MPAD / 256;
constexpr int NLN_TILES = NR / 32;
constexpr float ALPHA = 1.681792830507429f;
constexpr float LN_EPS = 1e-5f;
constexpr int MAXG = 1024;

constexpr size_t al256(size_t x) { return (x + 255) & ~(size_t)255; }
constexpr size_t WS_CTL = 0;
constexpr size_t WS_IOTA = 65536;
constexpr size_t WS_WIN = al256(WS_IOTA + (size_t)ROWS_ALL * 4);
constexpr size_t WS_WG = WS_WIN + (size_t)2 * 2048 * 1024 * 2;
constexpr size_t WS_WOUT = WS_WG + (size_t)2 * 4 * 512 * 256 * 2;
constexpr size_t WS_WQKV = WS_WOUT + (size_t)2 * 1024 * 1024 * 2;
constexpr size_t WS_WO = WS_WQKV + (size_t)2 * 1536 * 1024 * 2;
constexpr size_t WS_WEGU = WS_WO + (size_t)2 * 1024 * 1024 * 2;
constexpr size_t WS_WED = WS_WEGU + (size_t)4 * 64 * 512 * 1024 * 2;
constexpr size_t WS_WSGU = WS_WED + (size_t)4 * 64 * 1024 * 256 * 2;
constexpr size_t WS_WSD = WS_WSGU + (size_t)4 * 512 * 1024 * 2;
constexpr size_t WS_WRH = WS_WSD + (size_t)4 * 1024 * 256 * 2;
constexpr size_t WS_WRL = WS_WRH + (size_t)4 * 64 * 1024 * 2;
constexpr size_t WS_C8 = WS_WRL + (size_t)4 * 64 * 1024 * 2;
constexpr size_t WS_H = al256(WS_C8 + 2 * 1024 * 4);
constexpr size_t WS_HB = WS_H + (size_t)MPAD * 1024 * 4;
constexpr size_t WS_V = WS_HB + (size_t)MPAD * 1024 * 2;
constexpr size_t WS_U = WS_V + (size_t)MPAD * 1024 * 4;
constexpr int YP = 1088;
constexpr size_t U_BYTES = (size_t)ROWS_ALL * YP * 2;
constexpr int Y8P = 1152;
constexpr size_t ROWB = (size_t)MPAD * 1024 * 2;
constexpr size_t U_YB = 0, U_XR = ROWB, U_XC = 2 * ROWB, U_Z = 3 * ROWB, U_AB = 4 * ROWB;
constexpr size_t U_QB = 0, U_KV = ROWB, U_OB = ROWB + ROWB / 2;
constexpr size_t WS_ACT = WS_U + U_BYTES;
constexpr size_t WS_IDX = WS_ACT + (size_t)ROWS_ALL * 256 * 2;
constexpr size_t WS_WT = al256(WS_IDX + (size_t)NR * 8 * 4);
constexpr size_t WS_INV = al256(WS_WT + (size_t)NR * 8 * 4);
constexpr size_t WS_ROWTOK = al256(WS_INV + (size_t)NR * 8 * 4);
constexpr size_t WS_ROWW = al256(WS_ROWTOK + (size_t)RT_MAX * 4);
constexpr size_t WS_HIST = al256(WS_ROWW + (size_t)RT_MAX * 4);
constexpr size_t WS_TSTART = al256(WS_HIST + (size_t)MAXG * 64 * 4);
constexpr size_t WS_AGG = al256(WS_TSTART + 80 * 4);
constexpr size_t WS_STAT = al256(WS_AGG + (size_t)2 * 64 * 1024 * 8);
constexpr size_t WS_END = al256(WS_STAT + (size_t)MPAD * 8);
static_assert(U_AB + 2 * ROWB <= U_BYTES, "U too small");

struct Params {
    const float* x; const float* meta; const float* rg_w_in; const float* rg_b_in; const float* rg_conv_w; const float* rg_conv_b; const float* rg_w_gates; const float* rg_b_gates;
    const float* rg_a_param; const float* rg_w_out; const float* attn_w_qkv; const float* attn_sinks; const float* attn_w_o; const float* rel_table; const float* ln_gain; const float* ln_bias;
    const float* router_w; const float* router_bias; const float* ex_w_gu; const float* ex_w_down; const float* sh_w_gu; const float* sh_w_down;
    float* out; char* ws;
};

typedef __bf16 bf16x2_t __attribute__((ext_vector_type(2)));
DI unsigned pk_bf16(float lo, float hi) { const f32x2 v = {lo, hi}; return __builtin_bit_cast(unsigned, __builtin_convertvector(v, bf16x2_t)); }
DI bf16_t f2bf(float f) { return (bf16_t)(pk_bf16(f, 0.f) & 0xffffu); }
DI float bf2f(unsigned b) { return __uint_as_float(b << 16); }
DI float bflo(unsigned p) { return __uint_as_float(p << 16); }
DI float bfhi(unsigned p) { return __uint_as_float(p & 0xffff0000u); }
DI void res8(u32x4 hi, u32x4 lo, float (&h)[8]) {
    h[0] = bflo(hi.x) + bflo(lo.x); h[1] = bfhi(hi.x) + bfhi(lo.x); h[2] = bflo(hi.y) + bflo(lo.y); h[3] = bfhi(hi.y) + bfhi(lo.y);
    h[4] = bflo(hi.z) + bflo(lo.z); h[5] = bfhi(hi.z) + bfhi(lo.z); h[6] = bflo(hi.w) + bflo(lo.w); h[7] = bfhi(hi.w) + bfhi(lo.w);
}
DI float sigmoidf_(float x) { return __builtin_amdgcn_rcpf(1.0f + __expf(-x)); }
DI float gelu_tanh(float x) { const float u = 1.5957691216057308f * (x + 0.044715f * x * x * x); return x * sigmoidf_(u); }
DI float silu_mul(float g, float u) { return g * sigmoidf_(g) * u; }
DI void lru_gate(float gx, float ga, float xc, float c8  , float& la, float& bx) {
    const float gate_x = sigmoidf_(gx), gate_a = sigmoidf_(ga);
    la = c8 * gate_a;
    const float a = __expf(la);
    const float x2 = 2.0f * la;
    const float omp = -x2 * (1.0f + x2 * 0.5f * (1.0f + x2 * (1.0f / 3.0f) * (1.0f + x2 * 0.25f * (1.0f + x2 * 0.2f))));
    const float om = (x2 > -0.3f) ? omp : 1.0f - a * a;
    bx = xc * gate_x * __builtin_amdgcn_sqrtf(om);
}
DI int dpp_x1(int v) { return __builtin_amdgcn_mov_dpp(v, 0xB1, 0xF, 0xF, true); }
DI int dpp_x2(int v) { return __builtin_amdgcn_mov_dpp(v, 0x4E, 0xF, 0xF, true); }
DI int dpp_hm(int v) { return __builtin_amdgcn_mov_dpp(v, 0x141, 0xF, 0xF, true); }
DI float xor32(float x) {
    const auto r = __builtin_amdgcn_permlane32_swap(__builtin_bit_cast(unsigned, x), __builtin_bit_cast(unsigned, x), false, false);
    return __builtin_bit_cast(float, (threadIdx.x & 32) ? r[0] : r[1]);
}
DI float wave_sum(float v) {
    v += __builtin_bit_cast(float, __builtin_amdgcn_mov_dpp(__builtin_bit_cast(int, v), 0xB1, 0xF, 0xF, true));
    v += __builtin_bit_cast(float, __builtin_amdgcn_mov_dpp(__builtin_bit_cast(int, v), 0x4E, 0xF, 0xF, true));
    v += __builtin_bit_cast(float, __builtin_amdgcn_mov_dpp(__builtin_bit_cast(int, v), 0x141, 0xF, 0xF, true));
    v += __builtin_bit_cast(float, __builtin_amdgcn_mov_dpp(__builtin_bit_cast(int, v), 0x140, 0xF, 0xF, true));
    const int b = __builtin_bit_cast(int, v);
    return (__builtin_bit_cast(float, __builtin_amdgcn_readlane(b, 0)) + __builtin_bit_cast(float, __builtin_amdgcn_readlane(b, 16))) + (__builtin_bit_cast(float, __builtin_amdgcn_readlane(b, 32)) + __builtin_bit_cast(float, __builtin_amdgcn_readlane(b, 48)));
}

__device__ const unsigned char kBucket[160] = {
    0, 1, 2, 3, 4, 5, 6, 7, 8, 9, 10, 11, 12, 13, 14, 15, 16, 16, 16, 17, 17, 18, 18, 18, 19, 19, 19, 20, 20, 20, 20, 21, 21, 21, 21, 22, 22, 22, 22, 22, 23, 23, 23, 23, 23, 23, 24, 24, 24, 24, 24, 24,
    25, 25, 25, 25, 25, 25, 25, 26, 26, 26, 26, 26, 26, 26, 26, 27, 27, 27, 27, 27, 27, 27, 27, 27, 27, 28, 28, 28, 28, 28, 28, 28, 28, 28, 28, 29, 29, 29, 29, 29, 29, 29, 29, 29, 29, 29, 29,
    30, 30, 30, 30, 30, 30, 30, 30, 30, 30, 30, 30, 30, 30, 31, 31, 31, 31, 31, 31, 31, 31, 31, 31, 31, 31, 31, 31, 31, 31, 31, 31, 31, 31, 31, 31, 31, 31, 31, 31, 31, 31, 31, 31, 31, 31, 31,
    31, 31, 31, 31, 31, 31, 31, 31, 31, 31, 31, 31, 31, 31};

#define XB_TMO      128
#define XB_XCNT(j)  (256  + 64 * (j))
#define XB_XSUB(j)  (1280 + 64 * (j))
#define XB_XGEN(j)  (2304 + 64 * (j))
#define XB_TOP      3328
#define XB_TOPGEN   3392
#define XCD_BAR_WORDS 3456
#define XB_SPIN_CAP (1u << 22)
DI unsigned xb_ld(unsigned* p)              { return __hip_atomic_load(p, __ATOMIC_RELAXED, __HIP_MEMORY_SCOPE_AGENT); }
DI unsigned xb_add(unsigned* p, unsigned v) { return __hip_atomic_fetch_add(p, v, __ATOMIC_RELAXED, __HIP_MEMORY_SCOPE_AGENT); }
DI unsigned xb_xcc_id() { return (unsigned)__builtin_amdgcn_s_getreg((3 << 11) | 20) & 0xFu; }
#define XB_SPIN(cond, bar) do { unsigned _sp = 0; while (cond) { __builtin_amdgcn_s_sleep(1); \
    if ((++_sp & 255u) == 0u) { if (xb_ld(&(bar)[XB_TMO])) break; if (_sp > XB_SPIN_CAP) { atomicAdd(&(bar)[XB_TMO], 1u); break; } } } } while (0)
struct XcdBarrier { unsigned* bar; unsigned x; volatile LAS unsigned* st; };
DI XcdBarrier xcd_barrier_post(unsigned* bar, volatile LAS unsigned* st) {
    XcdBarrier b; b.bar = bar; b.x = xb_xcc_id(); b.st = st;
    if (threadIdx.x == 0) (void)xb_add(&bar[XB_XCNT(b.x)], 1u);
    return b;
}
DI void xcd_barrier_complete(unsigned* bar, unsigned x, unsigned& nloc, unsigned& nx) {
    const unsigned G = gridDim.x * gridDim.y * gridDim.z;
    unsigned sum, cnt, mine, sp = 0u;
    for (;;) {
        sum = 0u; cnt = 0u; mine = 0u;
#pragma unroll
        for (unsigned j = 0; j < 16; ++j) { const unsigned c = xb_ld(&bar[XB_XCNT(j)]); sum += c; cnt += (c > 0u) ? 1u : 0u; mine = (j == x) ? c : mine; }
        if (sum == G) break;
        __builtin_amdgcn_s_sleep(1);
        if ((++sp & 255u) == 0u) { if (xb_ld(&bar[XB_TMO])) break; if (sp > XB_SPIN_CAP) { atomicAdd(&bar[XB_TMO], 1u); break; } }
    }
    nloc = mine > 0u ? mine : 1u; nx = cnt > 0u ? cnt : 1u;
}
DI void xcd_barrier(const XcdBarrier& b) {
    asm volatile("s_waitcnt vmcnt(0)" ::: "memory");
    __syncthreads();
    if (threadIdx.x == 0) {
        unsigned* bar = b.bar;
        __builtin_amdgcn_s_waitcnt(0);
        unsigned nloc = b.st[0], nx = b.st[1];
        if (nloc == 0u) { xcd_barrier_complete(bar, b.x, nloc, nx); b.st[0] = nloc; b.st[1] = nx; }
        const unsigned old = xb_add(&bar[XB_XSUB(b.x)], 1u);
        const unsigned gen = old / nloc;
        if (old + 1u == (gen + 1u) * nloc) {
            __builtin_amdgcn_fence(__ATOMIC_RELEASE, "agent");
            asm volatile("s_waitcnt vmcnt(0)" ::: "memory");
            const unsigned og = xb_add(&bar[XB_TOP], 1u);
            const unsigned tg = og / nx;
            if (og + 1u == (tg + 1u) * nx) xb_add(&bar[XB_TOPGEN], 1u);
            else XB_SPIN(xb_ld(&bar[XB_TOPGEN]) == tg, bar);
            __builtin_amdgcn_fence(__ATOMIC_ACQUIRE, "agent");
            xb_add(&bar[XB_XGEN(b.x)], 1u);
            asm volatile("s_waitcnt vmcnt(0)" ::: "memory");
        } else {
            XB_SPIN(xb_ld(&bar[XB_XGEN(b.x)]) == gen, bar);
            __builtin_amdgcn_fence(__ATOMIC_ACQUIRE, "agent");
            asm volatile("s_waitcnt vmcnt(0)" ::: "memory");
        }
    }
    __syncthreads();
}

namespace pg8 {
constexpr int BM = 256, BK = 64, HALF = 128, HTB = HALF * BK * 2, STAGE_BYTES = 8 * HTB;
constexpr int IDXT_OFF = STAGE_BYTES + 8192;
__host__ __device__ __forceinline__ int lds_byte(int r, int c) { const int st = (r >> 4) * 2 + (c >> 5), rr = r & 15, cc = c & 31, ob = rr * 64 + cc * 2; return st * 1024 + (ob ^ (((ob >> 9) & 1) << 5)); }
__host__ __device__ __forceinline__ void stage_rc(int b, int& R, int& C) { const int st = b / 1024, sb = b % 1024, swz = sb ^ (((sb >> 9) & 1) << 5); R = (st >> 1) * 16 + swz / 64; C = (st & 1) * 32 + (swz % 64) / 2; }
__host__ __device__ __forceinline__ int perm32(int rho) { const int n = rho >> 4, i = rho & 15; return 8 * (i >> 2) + 4 * n + (i & 3); }

struct Unit { const char* A; const int* rows; const char* Bt; int arow; int orow; int pn; int aux; };

template <class Epi, class Sched>
DI void gemm_phase(LAS unsigned char* lds, const int tid, const int K, const unsigned lda_bytes, const Sched& S, const Epi& E) {
    const int wid = __builtin_amdgcn_readfirstlane(tid >> 6), lane = tid & 63, wr = wid >> 2, wc = wid & 3, fr = lane & 15, fq = lane >> 4;
    const int nt = K / BK;
    unsigned voffB[2], cofA[2]; int rsel[2];
#pragma unroll
    for (int i = 0; i < 2; ++i) { int R, C; stage_rc(tid * 16 + i * 8192, R, C); const int Rb = Epi::PERM ? ((R & ~31) + perm32(R & 31)) : R;
        voffB[i] = (unsigned)(Rb * K + C) * 2u; cofA[i] = (unsigned)C * 2u; rsel[i] = R; }
    const size_t kstep = (size_t)(BK * 2);
    const size_t hstep = (size_t)HALF * K * 2;
    const unsigned ldsw = (unsigned)wid * 1024u;
    const int aoff = lds_byte(wr * 64 + fr, fq * 8), boff = lds_byte(wc * 32 + fr, fq * 8);
#define PG8_SA(b, h) (((b) * 2 + (h)) * HTB)
#define PG8_SB(b, h) ((4 + (b) * 2 + (h)) * HTB)
#define PG8_STAGE(bufoff, gbase, voff) do { _Pragma("unroll") for (int _i = 0; _i < 2; ++_i) \
        __builtin_amdgcn_global_load_lds((const unsigned*)((const char*)(gbase) + (voff)[_i]), (LAS unsigned*)(lds + (bufoff) + ldsw + _i * 8192), 16, 0, 0); } while (0)
#define PG8_LDA(dst, b, h) do { _Pragma("unroll") for (int m = 0; m < 4; ++m) _Pragma("unroll") for (int k = 0; k < 2; ++k) dst[m][k] = *(const LAS bf16x8*)(lds + PG8_SA(b, h) + aoff + m * 2048 + k * 1024); } while (0)
#define PG8_LDB(dst, b, h) do { _Pragma("unroll") for (int n = 0; n < 2; ++n) _Pragma("unroll") for (int k = 0; k < 2; ++k) dst[n][k] = *(const LAS bf16x8*)(lds + PG8_SB(b, h) + boff + n * 2048 + k * 1024); } while (0)
#define PG8_MMA(ai, bj, At, Bt) do { __builtin_amdgcn_s_setprio(1); _Pragma("unroll") for (int m = 0; m < 4; ++m) _Pragma("unroll") for (int n = 0; n < 2; ++n) _Pragma("unroll") for (int k = 0; k < 2; ++k) \
        acc[ai][bj][m][n] = __builtin_amdgcn_mfma_f32_16x16x32_bf16(Bt[n][k], At[m][k], acc[ai][bj][m][n], 0, 0, 0); __builtin_amdgcn_s_setprio(0); } while (0)
#define PG8_WAIT_V(n) asm volatile("s_waitcnt vmcnt(" #n ")" ::: "memory")
#define PG8_WAIT_L(n) asm volatile("s_waitcnt lgkmcnt(" #n ")" ::: "memory")
#define PG8_BAR __builtin_amdgcn_s_barrier()
#define PG8_SCHED __builtin_amdgcn_sched_barrier(0)
    Unit cur, nxt; int ui = 0;
    if (!S.next(0, cur)) return;
    f32x4 acc[2][2][4][2];
#pragma unroll
    for (int a = 0; a < 2; ++a)
#pragma unroll
        for (int b = 0; b < 2; ++b)
#pragma unroll
            for (int m = 0; m < 4; ++m)
#pragma unroll
                for (int n = 0; n < 2; ++n) acc[a][b][m][n] = (f32x4){0.f, 0.f, 0.f, 0.f};
    bf16x8 At[4][2], B0[2][2], B1[2][2];
    unsigned vA0[2], vA1[2], o0[2], o1[2];
    LAS int* idxt = (LAS int*)(lds + IDXT_OFF);
#define PG8_IDX_DMA(u, slot) do { if (wid < 4) __builtin_amdgcn_global_load_lds((const unsigned*)((u).rows + wid * 64 + lane), (LAS unsigned*)(idxt + (slot) * 256 + wid * 64), 4, 0, 0); } while (0)
    if constexpr (Sched::GATHER) {
        PG8_IDX_DMA(cur, 0);
        asm volatile("s_waitcnt vmcnt(0)" ::: "memory"); __builtin_amdgcn_s_barrier();
#pragma unroll
        for (int i = 0; i < 2; ++i) { vA0[i] = (unsigned)idxt[rsel[i]] * lda_bytes + cofA[i]; vA1[i] = (unsigned)idxt[HALF + rsel[i]] * lda_bytes + cofA[i]; }
    } else {
#pragma unroll
        for (int i = 0; i < 2; ++i) { vA0[i] = (unsigned)(cur.arow + rsel[i]) * lda_bytes + cofA[i]; vA1[i] = vA0[i] + (unsigned)HALF * lda_bytes; }
    }
    const char* cA = cur.A; const char* cB = cur.Bt;
    PG8_STAGE(PG8_SB(0, 0), cB, voffB); PG8_STAGE(PG8_SB(0, 1), cB + hstep, voffB); PG8_STAGE(PG8_SA(0, 0), cA, vA0); PG8_STAGE(PG8_SA(0, 1), cA, vA1);
    if (wr == 1) PG8_BAR;
    PG8_WAIT_V(2); PG8_BAR;
    PG8_STAGE(PG8_SB(1, 0), cB + kstep, voffB); PG8_STAGE(PG8_SA(1, 0), cA + kstep, vA0); PG8_STAGE(PG8_SB(1, 1), cB + hstep + kstep, voffB);
    PG8_WAIT_V(6); PG8_BAR;
#pragma unroll 1
    for (;;) {
        const bool has_next = S.next(ui + 1, nxt);
        const char* nA = has_next ? nxt.A : cA; const char* nB = has_next ? nxt.Bt : cB;
        if constexpr (Sched::GATHER) { if (has_next) PG8_IDX_DMA(nxt, (ui + 1) & 1); }
#pragma unroll 1
        for (int t = 0; t < nt; t += 2) {
            const bool last = (t == nt - 2);
            const char* a1 = cA + (size_t)(t + 1) * kstep;
            const char* a2 = last ? nA : cA + (size_t)(t + 2) * kstep; const char* b2 = last ? nB : cB + (size_t)(t + 2) * kstep;
            const char* a3 = a2 + kstep; const char* b3 = b2 + kstep;
#pragma unroll
            for (int i = 0; i < 2; ++i) { o0[i] = vA0[i]; o1[i] = vA1[i]; }
            if (last && has_next) {
                if constexpr (Sched::GATHER) {
#pragma unroll
                    for (int i = 0; i < 2; ++i) { o0[i] = (unsigned)idxt[((ui + 1) & 1) * 256 + rsel[i]] * lda_bytes + cofA[i]; o1[i] = (unsigned)idxt[((ui + 1) & 1) * 256 + HALF + rsel[i]] * lda_bytes + cofA[i]; }
                } else {
#pragma unroll
                    for (int i = 0; i < 2; ++i) { o0[i] = (unsigned)(nxt.arow + rsel[i]) * lda_bytes + cofA[i]; o1[i] = o0[i] + (unsigned)HALF * lda_bytes; }
                }
            }
            PG8_LDB(B0, 0, 0); PG8_LDB(B1, 0, 1); PG8_SCHED; PG8_LDA(At, 0, 0); PG8_STAGE(PG8_SA(1, 1), a1, vA1);
            PG8_WAIT_V(8); PG8_WAIT_L(0); PG8_BAR; PG8_MMA(0, 0, At, B0); PG8_MMA(0, 1, At, B1); PG8_BAR; PG8_SCHED;
            PG8_LDA(At, 0, 1); PG8_STAGE(PG8_SB(0, 0), b2, voffB); PG8_STAGE(PG8_SB(0, 1), b2 + hstep, voffB); PG8_STAGE(PG8_SA(0, 0), a2, o0);
            PG8_WAIT_V(8); PG8_WAIT_L(0); PG8_BAR; PG8_MMA(1, 0, At, B0); PG8_MMA(1, 1, At, B1); PG8_BAR; PG8_SCHED;
            PG8_LDB(B0, 1, 0); PG8_LDB(B1, 1, 1); PG8_SCHED; PG8_LDA(At, 1, 0); PG8_STAGE(PG8_SA(0, 1), a2, o1);
            PG8_WAIT_V(8); PG8_WAIT_L(0); PG8_BAR; PG8_MMA(0, 0, At, B0); PG8_MMA(0, 1, At, B1); PG8_BAR; PG8_SCHED;
            PG8_LDA(At, 1, 1); PG8_STAGE(PG8_SB(1, 0), b3, voffB); PG8_STAGE(PG8_SB(1, 1), b3 + hstep, voffB); PG8_STAGE(PG8_SA(1, 0), a3, o0);
            PG8_WAIT_V(8); PG8_WAIT_L(0); PG8_BAR; PG8_MMA(1, 0, At, B0); PG8_MMA(1, 1, At, B1); PG8_BAR; PG8_SCHED;
        }
        if (wr == 0) PG8_BAR;
        E(acc, cur, wr, wc, fr, fq);
        if (!has_next) break;
#pragma unroll
        for (int a = 0; a < 2; ++a)
#pragma unroll
            for (int b = 0; b < 2; ++b)
#pragma unroll
                for (int m = 0; m < 4; ++m)
#pragma unroll
                    for (int n = 0; n < 2; ++n) acc[a][b][m][n] = (f32x4){0.f, 0.f, 0.f, 0.f};
        cur = nxt; cA = nA; cB = nB; ++ui;
#pragma unroll
        for (int i = 0; i < 2; ++i) { vA0[i] = o0[i]; vA1[i] = o1[i]; }
        if (wr == 1) PG8_BAR;
    }
    PG8_WAIT_V(0);
    PG8_BAR;
#undef PG8_IDX_DMA
#undef PG8_SA
#undef PG8_SB
#undef PG8_STAGE
#undef PG8_LDA
#undef PG8_LDB
#undef PG8_MMA
#undef PG8_WAIT_V
#undef PG8_WAIT_L
#undef PG8_BAR
#undef PG8_SCHED
}
}
using pg8::Unit;

DI int crow(int reg, int h) { return (reg & 3) + 8 * (reg >> 2) + 4 * h; }
template <int KW> DI void block_gemm32(LAS unsigned char* lds, const char* Ap, size_t lda, const char* Bp, size_t ldb, int wid, int lane, float (&x2)[2]) {
    const int r = lane & 31, h = lane >> 5;
    const char* a = Ap + (size_t)r * lda + (size_t)wid * KW * 2 + h * 16; const char* b = Bp + (size_t)r * ldb + (size_t)wid * KW * 2 + h * 16;
    bf16x8 av[KW / 16], bv[KW / 16];
#pragma unroll
    for (int s = 0; s < KW / 16; ++s) { av[s] = *(const bf16x8*)(a + s * 32); bv[s] = *(const bf16x8*)(b + s * 32); }
    f32x16 acc;
#pragma unroll
    for (int i = 0; i < 16; ++i) acc[i] = 0.f;
#pragma unroll
    for (int s = 0; s < KW / 16; ++s) acc = __builtin_amdgcn_mfma_f32_32x32x16_bf16(av[s], bv[s], acc, 0, 0, 0);
    LAS float* P = (LAS float*)lds;
#pragma unroll
    for (int i = 0; i < 16; ++i) P[(wid * 16 + i) * 64 + lane] = acc[i];
    __syncthreads();
#pragma unroll
    for (int ii = 0; ii < 2; ++ii) { float sum = 0.f;
#pragma unroll
        for (int p = 0; p < 8; ++p) sum += P[(p * 16 + 2 * wid + ii) * 64 + lane];
        x2[ii] = sum; }
    __syncthreads();
}

struct DenseSched {
    static constexpr bool GATHER = false;
    int nM, nN, nwg, G, c; const char* A; const int* iota; const char* Bt; int K; bool gates;
    DI void init(int nN_, int G_, int c_, const char* A_, const int* iota_, const char* Bt_, int K_, bool gates_) { nM = MR / 256; nN = nN_; nwg = nM * nN; G = G_; c = c_; A = A_; iota = iota_; Bt = Bt_; K = K_; gates = gates_; }
    DI bool next(int i, Unit& u) const {
        const long L = (long)i * G + c; if (L >= nwg) return false;
        int wgid = (int)L; { const int q = nwg / 8, r = nwg % 8, xcd = wgid % 8, off = wgid / 8; wgid = (xcd < r ? xcd * (q + 1) : r * (q + 1) + (xcd - r) * q) + off; }
        const int nig = 8 * nN, gid = wgid / nig, fm = gid * 8, gsz = (nM - fm) < 8 ? (nM - fm) : 8;
        const int pm = fm + ((wgid % nig) % gsz), pn = (wgid % nig) / gsz;
        u.A = A + (gates ? (size_t)(pn >> 1) * 512 : (size_t)0); u.rows = nullptr; u.arow = pm * 256; u.Bt = Bt + (size_t)pn * 256 * K * 2; u.orow = pm * 256; u.pn = pn; u.aux = 0;
        return true;
    }
};
template <bool DOWN> struct ExpertSched {
    static constexpr bool GATHER = !DOWN;
    static constexpr int NPN = DOWN ? 4 : 2, K = DOWN ? 256 : 1024, TPX = 32 / NPN, PER_ROUND = 8 * TPX;
    static constexpr size_t WSTRIDE = DOWN ? (size_t)1024 * 256 * 2 : (size_t)512 * 1024 * 2;
    int c, nrt; LAS const int* tile_e; const char* ws; const char* Wr; const char* Ws;
    DI bool next(int i, Unit& u) const {
        const int x = c & 7, s = c >> 3;
        const int tile = i * PER_ROUND + x * TPX + s / NPN, pn = s % NPN;
        if (tile >= nrt + N_SH_TILES) return false;
        u.A = ws + (DOWN ? WS_ACT : WS_HB); u.pn = pn;
        const int* iota = (const int*)(ws + WS_IOTA);
        if (tile < nrt) { const int e = __builtin_amdgcn_readfirstlane(tile_e[tile]); u.aux = e; u.orow = tile * 256; u.arow = u.orow; u.rows = DOWN ? nullptr : (const int*)(ws + WS_ROWTOK) + tile * 256; u.Bt = Wr + (size_t)e * WSTRIDE + (size_t)pn * 256 * K * 2; }
        else { const int t2 = tile - nrt; u.aux = -1; u.orow = SH_BASE + t2 * 256; u.arow = u.orow; u.rows = DOWN ? nullptr : iota + t2 * 256; u.Bt = Ws + (size_t)pn * 256 * K * 2; }
        return true;
    }
};

struct EpiWin {
    static constexpr bool PERM = true;
    bf16_t* YB; bf16_t* XR; const float* bias;
    DI void operator()(const f32x4 (&acc)[2][2][4][2], const Unit& u, int wr, int wc, int fr, int fq) const {
        const bool isy = u.pn < 4; bf16_t* base = isy ? YB : XR;
        const int colo = (isy ? u.pn : u.pn - 4) * 256 + wc * 32 + 8 * fq, bcol = u.pn * 256 + wc * 32 + 8 * fq;
        f32x4 bv[2][2];
#pragma unroll
        for (int bj = 0; bj < 2; ++bj)
#pragma unroll
            for (int n = 0; n < 2; ++n) bv[bj][n] = *(const f32x4*)(bias + bcol + bj * 128 + 4 * n);
#pragma unroll
        for (int ai = 0; ai < 2; ++ai)
#pragma unroll
            for (int m = 0; m < 4; ++m) { bf16_t* rowp = base + (size_t)(u.orow + ai * 128 + wr * 64 + m * 16 + fr) * 1024 + colo;
#pragma unroll
                for (int bj = 0; bj < 2; ++bj) { f32x4 v0 = acc[ai][bj][m][0] + bv[bj][0], v1 = acc[ai][bj][m][1] + bv[bj][1];
                    if (isy) {
#pragma unroll
                        for (int j = 0; j < 4; ++j) { v0[j] = gelu_tanh(v0[j]); v1[j] = gelu_tanh(v1[j]); } }
                    u32x4 w; w.x = pk_bf16(v0[0], v0[1]); w.y = pk_bf16(v0[2], v0[3]); w.z = pk_bf16(v1[0], v1[1]); w.w = pk_bf16(v1[2], v1[3]);
                    *(u32x4*)(rowp + bj * 128) = w; } }
    }
};
struct EpiGates {
    static constexpr bool PERM = false;
    unsigned* AB; const bf16_t* XC; const float* bg; const float* c8;
    DI void operator()(const f32x4 (&acc)[2][2][4][2], const Unit& u, int wr, int wc, int fr, int fq) const {
        const int nb = u.pn >> 1, ph = u.pn & 1;
#pragma unroll
        for (int n = 0; n < 2; ++n) {
            const int cl = ph * 128 + wc * 32 + 16 * n + 4 * fq;
            const int ch = nb * 256 + cl;
            const f32x4 bgx = *(const f32x4*)(bg + nb * 512 + cl), bga = *(const f32x4*)(bg + nb * 512 + 256 + cl), cc = *(const f32x4*)(c8 + ch);
            u32x2 xpv[2][4];
#pragma unroll
            for (int ai = 0; ai < 2; ++ai)
#pragma unroll
                for (int m = 0; m < 4; ++m) xpv[ai][m] = *(const u32x2*)(XC + (size_t)(u.orow + ai * 128 + wr * 64 + m * 16 + fr) * 1024 + ch);
            asm volatile("" ::: "memory");
#pragma unroll
            for (int ai = 0; ai < 2; ++ai)
#pragma unroll
                for (int m = 0; m < 4; ++m) {
                    const size_t row = (size_t)(u.orow + ai * 128 + wr * 64 + m * 16 + fr);
                    const u32x2 xp = xpv[ai][m];
                    const float xc[4] = {bflo(xp.x), bfhi(xp.x), bflo(xp.y), bfhi(xp.y)};
                    u32x4 w4;
#pragma unroll
                    for (int j = 0; j < 4; ++j) { float a, b; lru_gate(acc[ai][0][m][n][j] + bgx[j], acc[ai][1][m][n][j] + bga[j], xc[j], cc[j], a, b); w4[j] = pk_bf16(a, b); }
                    *(u32x4*)(AB + row * 1024 + ch) = w4;
                    asm volatile("" ::: "memory");
                }
        }
    }
};
struct EpiResid {
    static constexpr bool PERM = true;
    bf16_t* V; const float* x; const bf16_t* HB; const bf16_t* HLO;
    DI void operator()(const f32x4 (&acc)[2][2][4][2], const Unit& u, int wr, int wc, int fr, int fq) const {
        const int col0 = u.pn * 256 + wc * 32 + 8 * fq;
#pragma unroll
        for (int ai = 0; ai < 2; ++ai)
#pragma unroll
            for (int m = 0; m < 4; ++m) { const size_t ro = (size_t)(u.orow + ai * 128 + wr * 64 + m * 16 + fr) * 1024 + col0;
#pragma unroll
                for (int bj = 0; bj < 2; ++bj) {
                    float h[8];
                    if (x) { const f32x4 h0 = *(const f32x4*)(x + ro + bj * 128), h1 = *(const f32x4*)(x + ro + bj * 128 + 4); h[0] = h0[0]; h[1] = h0[1]; h[2] = h0[2]; h[3] = h0[3]; h[4] = h1[0]; h[5] = h1[1]; h[6] = h1[2]; h[7] = h1[3]; }
                    else res8(*(const u32x4*)(HB + ro + bj * 128), *(const u32x4*)(HLO + ro + bj * 128), h);
                    const f32x4 a0 = acc[ai][bj][m][0], a1 = acc[ai][bj][m][1];
                    u32x4 w; w.x = pk_bf16(h[0] * ALPHA + a0[0], h[1] * ALPHA + a0[1]); w.y = pk_bf16(h[2] * ALPHA + a0[2], h[3] * ALPHA + a0[3]);
                    w.z = pk_bf16(h[4] * ALPHA + a1[0], h[5] * ALPHA + a1[1]); w.w = pk_bf16(h[6] * ALPHA + a1[2], h[7] * ALPHA + a1[3]);
                    *(u32x4*)(V + ro + bj * 128) = w; } }
    }
};
struct EpiQkv {
    static constexpr bool PERM = true;
    bf16_t* Q; bf16_t* KV;
    DI void operator()(const f32x4 (&acc)[2][2][4][2], const Unit& u, int wr, int wc, int fr, int fq) const {
        const bool isq = u.pn < 4; bf16_t* base = isq ? Q : KV; const int ld = isq ? 1024 : 512;
        const int col0 = (isq ? u.pn : u.pn - 4) * 256 + wc * 32 + 8 * fq;
#pragma unroll
        for (int ai = 0; ai < 2; ++ai)
#pragma unroll
            for (int m = 0; m < 4; ++m) { bf16_t* rowp = base + (size_t)(u.orow + ai * 128 + wr * 64 + m * 16 + fr) * ld + col0;
#pragma unroll
                for (int bj = 0; bj < 2; ++bj) { const f32x4 v0 = acc[ai][bj][m][0], v1 = acc[ai][bj][m][1];
                    u32x4 w; w.x = pk_bf16(v0[0], v0[1]); w.y = pk_bf16(v0[2], v0[3]); w.z = pk_bf16(v1[0], v1[1]); w.w = pk_bf16(v1[2], v1[3]);
                    *(u32x4*)(rowp + bj * 128) = w; } }
    }
};
struct EpiGu {
    static constexpr bool PERM = true;
    bf16_t* ACT; const float* roww;
    DI void operator()(const f32x4 (&acc)[2][2][4][2], const Unit& u, int wr, int wc, int fr, int fq) const {
        const int col0 = u.pn * 128 + wc * 32 + 8 * fq;
        float w8[2][4];
#pragma unroll
        for (int ai = 0; ai < 2; ++ai)
#pragma unroll
            for (int m = 0; m < 4; ++m) w8[ai][m] = (u.aux >= 0) ? roww[u.orow + ai * 128 + wr * 64 + m * 16 + fr] : 1.0f;
#pragma unroll
        for (int ai = 0; ai < 2; ++ai)
#pragma unroll
            for (int m = 0; m < 4; ++m) { const int row = u.orow + ai * 128 + wr * 64 + m * 16 + fr;
                bf16_t* rowp = ACT + (size_t)row * 256 + col0;
                float v[8];
#pragma unroll
                for (int n = 0; n < 2; ++n)
#pragma unroll
                    for (int j = 0; j < 4; ++j) v[n * 4 + j] = silu_mul(acc[ai][0][m][n][j], acc[ai][1][m][n][j]) * w8[ai][m];
                u32x4 w; w.x = pk_bf16(v[0], v[1]); w.y = pk_bf16(v[2], v[3]); w.z = pk_bf16(v[4], v[5]); w.w = pk_bf16(v[6], v[7]);
                *(u32x4*)rowp = w; }
    }
};

constexpr int LDS_MISC = pg8::STAGE_BYTES;
constexpr int LDS_BYTES = LDS_MISC + 24576;
typedef const __attribute__((address_space(4))) unsigned long long* KArgPtr;
struct Ctx { KArgPtr kp; LAS unsigned char* lds; int G, blk, tid, wid, lane; };
DI Params load_params(KArgPtr k) {
    Params p;
    p.x = (const float*)k[0]; p.meta = (const float*)k[1]; p.rg_w_in = (const float*)k[2]; p.rg_b_in = (const float*)k[3]; p.rg_conv_w = (const float*)k[4]; p.rg_conv_b = (const float*)k[5];
    p.rg_w_gates = (const float*)k[6]; p.rg_b_gates = (const float*)k[7]; p.rg_a_param = (const float*)k[8]; p.rg_w_out = (const float*)k[9]; p.attn_w_qkv = (const float*)k[10]; p.attn_sinks = (const float*)k[11];
    p.attn_w_o = (const float*)k[12]; p.rel_table = (const float*)k[13]; p.ln_gain = (const float*)k[14]; p.ln_bias = (const float*)k[15]; p.router_w = (const float*)k[16]; p.router_bias = (const float*)k[17];
    p.ex_w_gu = (const float*)k[18]; p.ex_w_down = (const float*)k[19]; p.sh_w_gu = (const float*)k[20]; p.sh_w_down = (const float*)k[21]; p.out = (float*)k[22]; p.ws = (char*)k[23];
    return p;
}

DI void tr_tile(const float* src, int N, int k0, int n0, float scale, bf16_t* dst_row0  , int K, bf16_t* dst_lo, LAS bf16_t* T, int lane) {
#pragma unroll 4
    for (int it = 0; it < 8; ++it) {
        const int kk = it * 8 + 2 * (lane >> 4), c4 = (lane & 15) * 4;
        const f32x4 v0 = *(const f32x4*)(src + (size_t)(k0 + kk) * N + n0 + c4) * scale, v1 = *(const f32x4*)(src + (size_t)(k0 + kk + 1) * N + n0 + c4) * scale;
#pragma unroll
        for (int j = 0; j < 4; ++j) *(LAS unsigned*)(T + (c4 + j) * 72 + kk) = pk_bf16(v0[j], v1[j]);
    }
    __builtin_amdgcn_s_waitcnt(0xc07f);
#pragma unroll 4
    for (int it = 0; it < 8; ++it) {
        const int n = it * 8 + (lane >> 3), kc = (lane & 7) * 8;
        const u32x4 w = *(const LAS u32x4*)(T + n * 72 + kc);
        *(u32x4*)(dst_row0 + (size_t)n * K + kc) = w;
    }
    if (dst_lo) {
        __builtin_amdgcn_s_waitcnt(0xc07f);
#pragma unroll 4
        for (int it = 0; it < 8; ++it) {
            const int kk = it * 8 + 2 * (lane >> 4), c4 = (lane & 15) * 4;
            const f32x4 v0 = *(const f32x4*)(src + (size_t)(k0 + kk) * N + n0 + c4) * scale, v1 = *(const f32x4*)(src + (size_t)(k0 + kk + 1) * N + n0 + c4) * scale;
#pragma unroll
            for (int j = 0; j < 4; ++j) { const unsigned hi = pk_bf16(v0[j], v1[j]); *(LAS unsigned*)(T + (c4 + j) * 72 + kk) = pk_bf16(v0[j] - bflo(hi), v1[j] - bfhi(hi)); }
        }
        __builtin_amdgcn_s_waitcnt(0xc07f);
#pragma unroll 4
        for (int it = 0; it < 8; ++it) {
            const int n = it * 8 + (lane >> 3), kc = (lane & 7) * 8;
            const u32x4 w = *(const LAS u32x4*)(T + n * 72 + kc);
            *(u32x4*)(dst_lo + (size_t)n * K + kc) = w;
        }
    }
    __builtin_amdgcn_s_waitcnt(0xc07f);
}
struct Job { const float* src; bf16_t* dst; int count, K, N, mode; };
DI int pair_perm512(int n) { return ((n & 255) >> 7) * 256 + (n >> 8) * 128 + (n & 127); }

DI void phase_prologue(const Ctx& c) {
    const Params p = load_params(c.kp); char* ws = p.ws;
    LAS bf16_t* T = (LAS bf16_t*)(c.lds) + c.wid * (64 * 72);
    const int gw = c.blk * 8 + c.wid, nw = c.G * 8;
#pragma unroll 1
    for (int j = 0; j < 10; ++j) {
        Job jb;
        switch (j) {
            case 0: jb = Job{p.rg_w_in, (bf16_t*)(ws + WS_WIN), 2, 1024, 2048, 0}; break;
            case 1: jb = Job{p.rg_w_gates, (bf16_t*)(ws + WS_WG), 8, 256, 512, 1}; break;
            case 2: jb = Job{p.rg_w_out, (bf16_t*)(ws + WS_WOUT), 2, 1024, 1024, 0}; break;
            case 3: jb = Job{p.attn_w_qkv, (bf16_t*)(ws + WS_WQKV), 2, 1024, 1536, 2}; break;
            case 4: jb = Job{p.attn_w_o, (bf16_t*)(ws + WS_WO), 2, 1024, 1024, 0}; break;
            case 5: jb = Job{p.ex_w_gu, (bf16_t*)(ws + WS_WEGU), 256, 1024, 512, 1}; break;
            case 6: jb = Job{p.ex_w_down, (bf16_t*)(ws + WS_WED), 256, 256, 1024, 0}; break;
            case 7: jb = Job{p.sh_w_gu, (bf16_t*)(ws + WS_WSGU), 4, 1024, 512, 1}; break;
            case 8: jb = Job{p.sh_w_down, (bf16_t*)(ws + WS_WSD), 4, 256, 1024, 0}; break;
            default: jb = Job{p.router_w, (bf16_t*)(ws + WS_WRH), 4, 1024, 64, 3}; break;
        }
        const int tk = jb.K / 64, tn = jb.N / 64, per = tk * tn, total = jb.count * per;
        for (int t = gw; t < total; t += nw) {
            const int mi = t / per, r = t % per, kt = r / tn, ntl = r % tn;
            const float* src = jb.src + (size_t)mi * jb.K * jb.N;
            const int n0 = ntl * 64; int drow = n0; float scale = 1.0f;
            if (jb.mode == 1) drow = pair_perm512(n0);
            if (jb.mode == 2 && n0 < 1024) scale = 0.125f;
            bf16_t* dst = jb.dst + (size_t)mi * jb.K * jb.N + (size_t)drow * jb.K + kt * 64;
            bf16_t* dlo = (jb.mode == 3) ? (bf16_t*)(ws + WS_WRL) + (size_t)mi * jb.K * jb.N + (size_t)drow * jb.K + kt * 64 : nullptr;
            tr_tile(src, jb.N, kt * 64, n0, scale, dst, jb.K, dlo, T, c.lane);
        }
    }
    const size_t gt = (size_t)c.blk * 512 + c.tid, gn = (size_t)c.G * 512;
    bf16_t* HB = (bf16_t*)(ws + WS_HB); bf16_t* HLO = (bf16_t*)(ws + WS_H);
    for (size_t i = gt; i < (size_t)MR * 128; i += gn) {
        const f32x4 a = *(const f32x4*)(p.x + i * 8), b = *(const f32x4*)(p.x + i * 8 + 4);
        u32x4 w; w.x = pk_bf16(a[0], a[1]); w.y = pk_bf16(a[2], a[3]); w.z = pk_bf16(b[0], b[1]); w.w = pk_bf16(b[2], b[3]);
        *(u32x4*)(HB + i * 8) = w;
    }
    for (size_t i = gt; i < (size_t)(MPAD - MR) * 128; i += gn) {
        const int row = MR + (int)(i / 128), c8 = (int)(i % 128) * 8;
        u32x4 w = {0u, 0u, 0u, 0u};
        if (row < NR) { const int m = (row - MR) & 15; const f32x4 a = *(const f32x4*)(p.meta + m * 1024 + c8), b = *(const f32x4*)(p.meta + m * 1024 + c8 + 4);
            w.x = pk_bf16(a[0], a[1]); w.y = pk_bf16(a[2], a[3]); w.z = pk_bf16(b[0], b[1]); w.w = pk_bf16(b[2], b[3]);
            u32x4 l; l.x = pk_bf16(a[0] - bflo(w.x), a[1] - bfhi(w.x)); l.y = pk_bf16(a[2] - bflo(w.y), a[3] - bfhi(w.y)); l.z = pk_bf16(b[0] - bflo(w.z), b[1] - bfhi(w.z)); l.w = pk_bf16(b[2] - bflo(w.w), b[3] - bfhi(w.w));
            *(u32x4*)(HLO + (size_t)row * 1024 + c8) = l; }
        *(u32x4*)(HB + (size_t)row * 1024 + c8) = w;
    }
    int* iota = (int*)(ws + WS_IOTA);
    for (size_t i = gt; i < (size_t)ROWS_ALL; i += gn) iota[i] = (int)i;
    float* C8 = (float*)(ws + WS_C8);
    for (size_t i = gt; i < 2048; i += gn) { const float L = p.rg_a_param[i]; C8[i] = -8.0f * log1pf(expf(-L)); }
}


DI void phase_win(const Ctx& c, int j  ) {
    const Params p = load_params(c.kp); char* ws = p.ws;
    const bf16_t* HB = (const bf16_t*)(ws + WS_HB); const bf16_t* W = (const bf16_t*)(ws + WS_WIN) + (size_t)j * 2048 * 1024;
    bf16_t* YB = (bf16_t*)(ws + WS_U + U_YB); bf16_t* XR = (bf16_t*)(ws + WS_U + U_XR); const float* bias = p.rg_b_in + j * 2048;
    const int mt = c.G - 1 - c.blk;
    if (mt < 64) {
        float x2[2]; block_gemm32<128>(c.lds, (const char*)(HB + (size_t)MR * 1024), 2048, (const char*)(W + (size_t)mt * 32 * 1024), 2048, c.wid, c.lane, x2);
        const int r = c.lane & 31, h = c.lane >> 5, col = mt * 32 + r; const float b = bias[col];
#pragma unroll
        for (int ii = 0; ii < 2; ++ii) { const int row = MR + crow(2 * c.wid + ii, h); const float v = x2[ii] + b;
            if (col < 1024) YB[(size_t)row * 1024 + col] = f2bf(gelu_tanh(v)); else XR[(size_t)row * 1024 + col - 1024] = f2bf(v); }
    }
    DenseSched S; S.init(8, c.G, c.blk, (const char*)HB, (const int*)(ws + WS_IOTA), (const char*)W, 1024, false);
    EpiWin E{YB, XR, bias};
    pg8::gemm_phase(c.lds, c.tid, 1024, 2048u, S, E);
}
DI void load_xr8(const bf16_t* XR, int b, int s, int c8, float (&v)[8]) {
    if (s < -NMETA) {
#pragma unroll
        for (int i = 0; i < 8; ++i) v[i] = 0.f; return; }
    const size_t row = s >= 0 ? (size_t)b * SEQ + s : (size_t)MR + b * NMETA + (s + NMETA);
    const u32x4 w = *(const u32x4*)(XR + row * 1024 + c8);
    v[0] = bflo(w.x); v[1] = bfhi(w.x); v[2] = bflo(w.y); v[3] = bfhi(w.y); v[4] = bflo(w.z); v[5] = bfhi(w.z); v[6] = bflo(w.w); v[7] = bfhi(w.w);
}
DI void phase_conv(const Ctx& c, int j) {
    const Params p = load_params(c.kp); char* ws = p.ws;
    const bf16_t* XR = (const bf16_t*)(ws + WS_U + U_XR); bf16_t* XC = (bf16_t*)(ws + WS_U + U_XC);
    const int c8 = (c.tid & 127) * 8, sub = c.tid >> 7;
    float w0[8], w1[8], w2[8], w3[8], cb[8];
#pragma unroll
    for (int i = 0; i < 8; ++i) { w0[i] = p.rg_conv_w[(j * 4 + 0) * 1024 + c8 + i]; w1[i] = p.rg_conv_w[(j * 4 + 1) * 1024 + c8 + i]; w2[i] = p.rg_conv_w[(j * 4 + 2) * 1024 + c8 + i]; w3[i] = p.rg_conv_w[(j * 4 + 3) * 1024 + c8 + i]; cb[i] = p.rg_conv_b[j * 1024 + c8 + i]; }
    for (int tile = c.blk; tile < 513; tile += c.G) {
        int b, s0;
        if (tile < 512) { b = tile >> 8; s0 = (tile & 255) * 64 + sub * 16; }
        else { if (sub >= 2) continue; b = sub; s0 = -NMETA; }
        float x3[8], x2[8], x1[8], x0[8];
        load_xr8(XR, b, s0 - 3, c8, x3); load_xr8(XR, b, s0 - 2, c8, x2); load_xr8(XR, b, s0 - 1, c8, x1);
#pragma unroll 4
        for (int k = 0; k < 16; ++k) {
            const int s = s0 + k;
            load_xr8(XR, b, s, c8, x0);
            float o[8];
#pragma unroll
            for (int i = 0; i < 8; ++i) o[i] = cb[i] + w0[i] * x3[i] + w1[i] * x2[i] + w2[i] * x1[i] + w3[i] * x0[i];
            const size_t row = s >= 0 ? (size_t)b * SEQ + s : (size_t)MR + b * NMETA + (s + NMETA);
            u32x4 w; w.x = pk_bf16(o[0], o[1]); w.y = pk_bf16(o[2], o[3]); w.z = pk_bf16(o[4], o[5]); w.w = pk_bf16(o[6], o[7]);
            *(u32x4*)(XC + row * 1024 + c8) = w;
#pragma unroll
            for (int i = 0; i < 8; ++i) { x3[i] = x2[i]; x2[i] = x1[i]; x1[i] = x0[i]; }
        }
    }
}
struct GatesSched {
    static constexpr bool GATHER = false;
    int c; const char* A; const char* Bt;
    DI bool next(int i, Unit& u) const {
        if (i >= 4) return false;
        const int T = c + 256 * (i >> 1), ph = i & 1, pm = T >> 2, nb = T & 3, cn = nb * 2 + ph;
        u.A = A + (size_t)nb * 512; u.rows = nullptr; u.arow = pm * 256; u.Bt = Bt + (size_t)cn * 256 * 256 * 2; u.orow = pm * 256; u.pn = cn; u.aux = 0;
        return true;
    }
};
DI void conv_block(const Params& p, int j, const bf16_t* XR, bf16_t* XC, int b, int s0, int ch0, int ngroups, int tid) {
    const int c8 = ch0 + (tid & 31) * 8, grp = tid >> 5;
    if (grp >= ngroups) return;
    float w0[8], w1[8], w2[8], w3[8], cb[8];
#pragma unroll
    for (int i = 0; i < 8; ++i) { w0[i] = p.rg_conv_w[(j * 4 + 0) * 1024 + c8 + i]; w1[i] = p.rg_conv_w[(j * 4 + 1) * 1024 + c8 + i]; w2[i] = p.rg_conv_w[(j * 4 + 2) * 1024 + c8 + i]; w3[i] = p.rg_conv_w[(j * 4 + 3) * 1024 + c8 + i]; cb[i] = p.rg_conv_b[j * 1024 + c8 + i]; }
    const int sb = s0 + grp * 16;
    float x3[8], x2[8], x1[8], x0[8];
    load_xr8(XR, b, sb - 3, c8, x3); load_xr8(XR, b, sb - 2, c8, x2); load_xr8(XR, b, sb - 1, c8, x1);
#pragma unroll 4
    for (int k = 0; k < 16; ++k) {
        const int s = sb + k;
        load_xr8(XR, b, s, c8, x0);
        float o[8];
#pragma unroll
        for (int i = 0; i < 8; ++i) o[i] = cb[i] + w0[i] * x3[i] + w1[i] * x2[i] + w2[i] * x1[i] + w3[i] * x0[i];
        const size_t row = s >= 0 ? (size_t)b * SEQ + s : (size_t)MR + b * NMETA + (s + NMETA);
        u32x4 w; w.x = pk_bf16(o[0], o[1]); w.y = pk_bf16(o[2], o[3]); w.z = pk_bf16(o[4], o[5]); w.w = pk_bf16(o[6], o[7]);
        *(u32x4*)(XC + row * 1024 + c8) = w;
#pragma unroll
        for (int i = 0; i < 8; ++i) { x3[i] = x2[i]; x2[i] = x1[i]; x1[i] = x0[i]; }
    }
}
DI void phase_gates(const Ctx& c, int j) {
    const Params p = load_params(c.kp); char* ws = p.ws;
    const bf16_t* XR = (const bf16_t*)(ws + WS_U + U_XR); bf16_t* XCw = (bf16_t*)(ws + WS_U + U_XC);
    const bf16_t* XC = (const bf16_t*)(ws + WS_U + U_XC); const bf16_t* W = (const bf16_t*)(ws + WS_WG) + (size_t)j * 4 * 512 * 256;
    unsigned* AB = (unsigned*)(ws + WS_U + U_AB);
    const float* bg = p.rg_b_gates + j * 2048; const float* c8 = (const float*)(ws + WS_C8) + j * 1024;
    const int mt = c.G - 1 - c.blk;
#pragma unroll 1
    for (int i = 0; i < 2; ++i) { const int T = c.blk + 256 * i, pm = T >> 2, nb = T & 3; conv_block(p, j, XR, XCw, pm >> 6, (pm & 63) * 256, nb * 256, 16, c.tid); }
    if (mt < 32) { const int nb = mt >> 3; conv_block(p, j, XR, XCw, (c.tid >> 5) & 1, -NMETA - 16 * ((c.tid >> 5) & 1), nb * 256, 2, c.tid); }
    asm volatile("s_waitcnt vmcnt(0)" ::: "memory");
    __syncthreads();
    __builtin_amdgcn_fence(__ATOMIC_ACQUIRE, "agent");
    asm volatile("s_waitcnt vmcnt(0)" ::: "memory");
    if (mt < 32) {
        const int nb = mt >> 3, ph = (mt >> 2) & 1, q = mt & 3;
        const char* Ap = (const char*)(XC + (size_t)MR * 1024 + nb * 256);
        const bf16_t* Wt = W + (size_t)(nb * 512 + ph * 256) * 256;
        float gx[2], ga[2];
        block_gemm32<32>(c.lds, Ap, 2048, (const char*)(Wt + (size_t)(q * 32) * 256), 512, c.wid, c.lane, gx);
        block_gemm32<32>(c.lds, Ap, 2048, (const char*)(Wt + (size_t)(128 + q * 32) * 256), 512, c.wid, c.lane, ga);
        const int r = c.lane & 31, h = c.lane >> 5, cl = ph * 128 + q * 32 + r, ch = nb * 256 + cl;
        const float bgx = bg[nb * 512 + cl], bga = bg[nb * 512 + 256 + cl], cc = c8[ch];
#pragma unroll
        for (int ii = 0; ii < 2; ++ii) { const size_t row = (size_t)(MR + crow(2 * c.wid + ii, h)); float a, b; lru_gate(gx[ii] + bgx, ga[ii] + bga, bf2f(XC[row * 1024 + ch]), cc, a, b);
            AB[row * 1024 + ch] = pk_bf16(a, b); }
    }
    GatesSched S; S.c = c.blk; S.A = (const char*)XC; S.Bt = (const char*)W;
    EpiGates E{AB, XC, bg, c8};
    pg8::gemm_phase(c.lds, c.tid, 256, 2048u, S, E);
    __builtin_amdgcn_fence(__ATOMIC_ACQUIRE, "agent");
    {
        const int T = c.blk + 256 * (c.tid >> 8), pm = T >> 2, nb = T & 3, ch = nb * 256 + (c.tid & 255);
        const size_t row0 = (size_t)pm * 256; f32x2* AGG = (f32x2*)(ws + WS_AGG);
        float A = 1.f, Hh = 0.f;
#pragma unroll 1
        for (int t = 0; t < 256; t += 32) {
            unsigned w[32];
#pragma unroll
            for (int k = 0; k < 32; ++k) w[k] = AB[(row0 + t + k) * 1024 + ch];
#pragma unroll
            for (int k = 0; k < 32; ++k) { const float a = __expf(bflo(w[k])); Hh = a * Hh + bfhi(w[k]); A *= a; }
        }
        AGG[(size_t)pm * 1024 + ch] = (f32x2){A, Hh};
    }
}
DI void phase_scan1(const Ctx& c) {
    char* ws = (char*)c.kp[23];
    const unsigned* AB = (const unsigned*)(ws + WS_U + U_AB); f32x2* AGG = (f32x2*)(ws + WS_AGG);
    for (int item = c.blk; item < 256; item += c.G) {
        const int bc = item >> 1, ch = (item & 1) * 512 + c.tid;
        const size_t row0 = (size_t)bc * 256;
        float A = 1.f, Hh = 0.f;
#pragma unroll 1
        for (int t = 0; t < 256; t += 32) {
            unsigned w[32];
#pragma unroll
            for (int k = 0; k < 32; ++k) w[k] = AB[(row0 + t + k) * 1024 + ch];
#pragma unroll
            for (int k = 0; k < 32; ++k) { const float a = __expf(bflo(w[k])); Hh = a * Hh + bfhi(w[k]); A *= a; }
        }
        AGG[(size_t)bc * 1024 + ch] = (f32x2){A, Hh};
    }
}
DI void phase_scan2(const Ctx& c) {
    char* ws = (char*)c.kp[23];
    const unsigned* AB = (const unsigned*)(ws + WS_U + U_AB); const f32x2* AGG = (const f32x2*)(ws + WS_AGG);
    const bf16_t* YB = (const bf16_t*)(ws + WS_U + U_YB); bf16_t* Z = (bf16_t*)(ws + WS_U + U_Z);
    for (int item = c.blk; item < 256; item += c.G) {
        const int bc = item >> 1, b = bc >> 6, chunk = bc & 63, ch = (item & 1) * 512 + c.tid;
        float h = 0.f;
        {
            unsigned w[NMETA]; float y[NMETA];
#pragma unroll
            for (int m = 0; m < NMETA; ++m) { const size_t row = (size_t)MR + b * NMETA + m; w[m] = AB[row * 1024 + ch]; y[m] = bf2f(YB[row * 1024 + ch]); }
#pragma unroll
            for (int m = 0; m < NMETA; ++m) { const size_t row = (size_t)MR + b * NMETA + m; h = __expf(bflo(w[m])) * h + bfhi(w[m]); if (chunk == 0) Z[row * 1024 + ch] = f2bf(y[m] * h); }
        }
#pragma unroll 1
        for (int c0 = 0; c0 < chunk; c0 += 16) {
            f32x2 g[16];
#pragma unroll
            for (int k = 0; k < 16; ++k) g[k] = (c0 + k < chunk) ? AGG[(size_t)(b * 64 + c0 + k) * 1024 + ch] : (f32x2){1.f, 0.f};
#pragma unroll
            for (int k = 0; k < 16; ++k) h = g[k].x * h + g[k].y;
        }
        const size_t row0 = (size_t)bc * 256;
#pragma unroll 1
        for (int t = 0; t < 256; t += 32) {
            unsigned w[32]; unsigned short y[32];
#pragma unroll
            for (int k = 0; k < 32; ++k) { w[k] = AB[(row0 + t + k) * 1024 + ch]; y[k] = YB[(row0 + t + k) * 1024 + ch]; }
#pragma unroll
            for (int k = 0; k < 32; ++k) { h = __expf(bflo(w[k])) * h + bfhi(w[k]); Z[(row0 + t + k) * 1024 + ch] = f2bf(bf2f(y[k]) * h); }
        }
    }
}
DI void phase_outproj(const Ctx& c, const bf16_t* A, const bf16_t* W, bool first_layer) {
    const Params p = load_params(c.kp); char* ws = p.ws;
    bf16_t* V = (bf16_t*)(ws + WS_V); const bf16_t* HB = (const bf16_t*)(ws + WS_HB); const bf16_t* HLO = (const bf16_t*)(ws + WS_H);
    const int mt = c.G - 1 - c.blk;
    if (mt < 32) {
        float x2[2]; block_gemm32<128>(c.lds, (const char*)(A + (size_t)MR * 1024), 2048, (const char*)(W + (size_t)mt * 32 * 1024), 2048, c.wid, c.lane, x2);
        const int r = c.lane & 31, h = c.lane >> 5, col = mt * 32 + r;
#pragma unroll
        for (int ii = 0; ii < 2; ++ii) { const size_t row = (size_t)(MR + crow(2 * c.wid + ii, h)); V[row * 1024 + col] = f2bf(ALPHA * (bf2f(HB[row * 1024 + col]) + bf2f(HLO[row * 1024 + col])) + x2[ii]); }
    }
    DenseSched S; S.init(4, c.G, c.blk, (const char*)A, (const int*)(ws + WS_IOTA), (const char*)W, 1024, false);
    EpiResid E{V, first_layer ? p.x : nullptr, HB, HLO};
    pg8::gemm_phase(c.lds, c.tid, 1024, 2048u, S, E);
}
DI void phase_qkv(const Ctx& c, int j) {
    const Params p = load_params(c.kp); char* ws = p.ws;
    const bf16_t* HB = (const bf16_t*)(ws + WS_HB); const bf16_t* W = (const bf16_t*)(ws + WS_WQKV) + (size_t)j * 1536 * 1024;
    bf16_t* Q = (bf16_t*)(ws + WS_U + U_QB); bf16_t* KV = (bf16_t*)(ws + WS_U + U_KV);
    const int mt = c.G - 1 - c.blk;
    if (mt < 48) {
        float x2[2]; block_gemm32<128>(c.lds, (const char*)(HB + (size_t)MR * 1024), 2048, (const char*)(W + (size_t)mt * 32 * 1024), 2048, c.wid, c.lane, x2);
        const int r = c.lane & 31, h = c.lane >> 5, col = mt * 32 + r;
#pragma unroll
        for (int ii = 0; ii < 2; ++ii) { const size_t row = (size_t)(MR + crow(2 * c.wid + ii, h)); const bf16_t v = f2bf(x2[ii]);
            if (col < 1024) Q[row * 1024 + col] = v; else KV[row * 512 + col - 1024] = v; }
    }
    DenseSched S; S.init(6, c.G, c.blk, (const char*)HB, (const int*)(ws + WS_IOTA), (const char*)W, 1024, false);
    EpiQkv E{Q, KV};
    pg8::gemm_phase(c.lds, c.tid, 1024, 2048u, S, E);
}
constexpr int AT_KP = 72, AT_VP = 296;
constexpr int AT_K_OFF = 0, AT_V_OFF = 288 * AT_KP * 2, AT_B_OFF = AT_V_OFF + 64 * AT_VP * 2;
DI bf16x8 pack_step(const f32x16& x, int s) {
    u32x4 p;
    p.x = pk_bf16(x[8 * s], x[8 * s + 1]); p.y = pk_bf16(x[8 * s + 2], x[8 * s + 3]); p.z = pk_bf16(x[8 * s + 4], x[8 * s + 5]); p.w = pk_bf16(x[8 * s + 6], x[8 * s + 7]);
    return __builtin_bit_cast(bf16x8, p);
}
DI void phase_attn(const Ctx& c, int j) {
    const Params p = load_params(c.kp); char* ws = p.ws;
    const bf16_t* Q = (const bf16_t*)(ws + WS_U + U_QB); const bf16_t* KV = (const bf16_t*)(ws + WS_U + U_KV);
    bf16_t* O = (bf16_t*)(ws + WS_U + U_OB);
    LAS bf16_t* KI = (LAS bf16_t*)(c.lds + AT_K_OFF); LAS bf16_t* VT = (LAS bf16_t*)(c.lds + AT_V_OFF); LAS float* BT = (LAS float*)(c.lds + AT_B_OFF); LAS float* BTX = (LAS float*)(c.lds + AT_B_OFF + 2560);
    const int lane = c.lane, r = lane & 31, h = lane >> 5, g = c.wid >> 1, qh = c.wid & 1;
    for (int item = c.blk; item < 1032; item += c.G) {
        const bool ismeta = item >= 1024;
        int b, n, hk;
        if (!ismeta) { hk = item & 3; n = (item >> 2) & 127; b = item >> 9; } else { hk = item & 3; b = (item - 1024) >> 2; n = -1; }
        const int head = hk * 4 + g;
        bf16x8 qf[2][4];
        int qi[2];
#pragma unroll
        for (int cb = 0; cb < 2; ++cb) {
            qi[cb] = qh * 64 + cb * 32 + r;
            size_t qrow;
            if (!ismeta) qrow = (size_t)b * SEQ + n * 128 + qi[cb]; else qrow = (size_t)MR + b * NMETA + (qi[cb] & 15);
#pragma unroll
            for (int ks = 0; ks < 4; ++ks) qf[cb][ks] = *(const bf16x8*)(Q + qrow * 1024 + head * 64 + ks * 16 + h * 8);
        }
        __syncthreads();
        {
            u32x4 kvv[5], vvv[5];
#pragma unroll
            for (int it = 0; it < 5; ++it) {
                const int ch = c.tid + 512 * it, kk = ch >> 3, d8 = (ch & 7) * 8;
                long row = -1;
                if (ch < 288 * 8) {
                    if (kk < 16) row = (long)MR + b * NMETA + kk;
                    else if (kk >= 32 && !ismeta) { const int t = n * 128 - 128 + (kk - 32); if (t >= 0) row = (long)b * SEQ + t; }
                }
                kvv[it] = (u32x4){0u, 0u, 0u, 0u}; vvv[it] = (u32x4){0u, 0u, 0u, 0u};
                if (row >= 0) { kvv[it] = *(const u32x4*)(KV + (size_t)row * 512 + hk * 64 + d8); vvv[it] = *(const u32x4*)(KV + (size_t)row * 512 + 256 + hk * 64 + d8); }
            }
#pragma unroll
            for (int it = 0; it < 5; ++it) {
                const int ch = c.tid + 512 * it, kk = ch >> 3, d8 = (ch & 7) * 8;
                if (ch < 288 * 8) {
                    *(LAS u32x4*)(KI + kk * AT_KP + d8) = kvv[it];
                    const int kin = kk & 15, pos = (kk & ~15) | (((kin >> 2) & 1) << 3) | (((kin >> 3) & 1) << 2) | (kin & 3);
                    const unsigned vw[4] = {vvv[it].x, vvv[it].y, vvv[it].z, vvv[it].w};
#pragma unroll
                    for (int i = 0; i < 4; ++i) { VT[(d8 + 2 * i) * AT_VP + pos] = (bf16_t)(vw[i] & 0xffffu); VT[(d8 + 2 * i + 1) * AT_VP + pos] = (bf16_t)(vw[i] >> 16); }
                }
            }
        }
        for (int i = c.tid; i < 4 * 160; i += 512) { const int gg = i / 160, d = i % 160; BT[i] = p.rel_table[kBucket[d] * 16 + hk * 4 + gg]; }
        for (int i = c.tid; i < 4 * 448; i += 512) { const int gg = i / 448, d = i % 448 - 160; BTX[i] = (d >= 0 && d < 128) ? p.rel_table[kBucket[d] * 16 + hk * 4 + gg] : -1e30f; }
        __syncthreads();
        f32x16 o[2][2];
#pragma unroll
        for (int db = 0; db < 2; ++db)
#pragma unroll
            for (int cb = 0; cb < 2; ++cb)
#pragma unroll
                for (int i = 0; i < 16; ++i) o[db][cb][i] = 0.f;
        float mrun[2] = {-1e30f, -1e30f}, lrun[2] = {0.f, 0.f};
        int kt_lo, kt_hi;
        if (ismeta) { kt_lo = 1; kt_hi = 0; }
        else if (qh == 0) { kt_lo = (n == 0) ? 5 : 1; kt_hi = 6; }
        else { kt_lo = (n == 0) ? 5 : 3; kt_hi = 8; }
        const bool active = !(ismeta && qh == 1);
        if (active) {
            for (int it = 0; it <= kt_hi - kt_lo + 1; ++it) {
                const int kt = (it == 0) ? 0 : kt_lo + it - 1;
                f32x16 s[2];
#pragma unroll
                for (int cb = 0; cb < 2; ++cb)
#pragma unroll
                    for (int i = 0; i < 16; ++i) s[cb][i] = 0.f;
#pragma unroll
                for (int ks = 0; ks < 4; ++ks) {
                    const bf16x8 kf = *(const LAS bf16x8*)(KI + (kt * 32 + r) * AT_KP + ks * 16 + h * 8);
#pragma unroll
                    for (int cb = 0; cb < 2; ++cb) s[cb] = __builtin_amdgcn_mfma_f32_32x32x16_bf16(kf, qf[cb][ks], s[cb], 0, 0, 0);
                }
                bf16x8 pf[2][2];
#pragma unroll
                for (int cb = 0; cb < 2; ++cb) {
                    float tmax = -1e30f;
                    if (kt == 0) {
#pragma unroll
                        for (int i = 0; i < 16; ++i) {
                            const int kr = crow(i, h);
                            bool valid; int d;
                            if (ismeta) { d = (qi[cb] & 15) - kr; valid = (kr < 16) && d >= 0; } else { d = NMETA + n * 128 + qi[cb] - kr; valid = kr < 16; }
                            d = d < 0 ? 0 : (d > 159 ? 159 : d);
                            const float sv = valid ? s[cb][i] + BT[g * 160 + d] : -1e30f;
                            s[cb][i] = sv; tmax = fmaxf(tmax, sv);
                        }
                    } else {
                        LAS const float* bx = BTX + g * 448 + (288 + qi[cb] - 32 * (kt - 1) - 4 * h - 27);
#pragma unroll
                        for (int i = 0; i < 16; ++i) { const float sv = s[cb][i] + bx[27 - ((i & 3) + 8 * (i >> 2))]; s[cb][i] = sv; tmax = fmaxf(tmax, sv); }
                    }
                    tmax = fmaxf(tmax, xor32(tmax));
                    const float mnew = fmaxf(mrun[cb], tmax), alpha = __expf(mrun[cb] - mnew);
                    float psum = 0.f;
#pragma unroll
                    for (int i = 0; i < 16; ++i) { const float pv = __expf(s[cb][i] - mnew); s[cb][i] = pv; psum += pv; }
                    lrun[cb] = lrun[cb] * alpha + psum; mrun[cb] = mnew;
#pragma unroll
                    for (int db = 0; db < 2; ++db)
#pragma unroll
                        for (int i = 0; i < 16; ++i) o[db][cb][i] *= alpha;
                    pf[cb][0] = pack_step(s[cb], 0); pf[cb][1] = pack_step(s[cb], 1);
                }
#pragma unroll
                for (int ss = 0; ss < 2; ++ss)
#pragma unroll
                    for (int db = 0; db < 2; ++db) {
                        const bf16x8 vf = *(const LAS bf16x8*)(VT + (db * 32 + r) * AT_VP + kt * 32 + ss * 16 + h * 8);
#pragma unroll
                        for (int cb = 0; cb < 2; ++cb) o[db][cb] = __builtin_amdgcn_mfma_f32_32x32x16_bf16(vf, pf[cb][ss], o[db][cb], 0, 0, 0);
                    }
            }
            const float sink = p.attn_sinks[j * 16 + head];
#pragma unroll
            for (int cb = 0; cb < 2; ++cb) {
                const float ltot = lrun[cb] + xor32(lrun[cb]);
                const float mf = fmaxf(mrun[cb], sink), e1 = __expf(mrun[cb] - mf), den = ltot * e1 + __expf(sink - mf), sc = e1 / den;
                const bool st = ismeta ? (cb == 0 && r < 16) : true;
                if (st) {
                    const size_t qrow = ismeta ? (size_t)MR + b * NMETA + r : (size_t)b * SEQ + n * 128 + qi[cb];
#pragma unroll
                    for (int db = 0; db < 2; ++db)
#pragma unroll
                        for (int q4 = 0; q4 < 4; ++q4) {
                            u32x2 w; w.x = pk_bf16(o[db][cb][4 * q4] * sc, o[db][cb][4 * q4 + 1] * sc); w.y = pk_bf16(o[db][cb][4 * q4 + 2] * sc, o[db][cb][4 * q4 + 3] * sc);
                            *(u32x2*)(O + qrow * 1024 + head * 64 + db * 32 + 8 * q4 + 4 * h) = w;
                        }
                }
            }
        }
    }
    __syncthreads();
}
constexpr int LN_AP = 1032;
constexpr int LN_AHI = 0, LN_ALO = 32 * LN_AP * 2;
constexpr int LN_PART = 0;
constexpr int LN_SC = 133120;
constexpr int LN_CH = LN_SC + 32 * 65 * 4;
constexpr int LN_HIST = LN_CH + 32 * 65 * 4;
static_assert(LN_ALO + 32 * LN_AP * 2 <= LN_SC && LN_HIST + 256 <= LDS_BYTES, "LN LDS map");
DI void phase_lnr(const Ctx& c, int layer) {
    const Params p = load_params(c.kp); char* ws = p.ws;
    const bf16_t* V = (const bf16_t*)(ws + WS_V); float* STAT = (float*)(ws + WS_STAT); bf16_t* HB = (bf16_t*)(ws + WS_HB);
    const float* gain = p.ln_gain + (layer * 2 + 0) * 1024; const float* bias = p.ln_bias + (layer * 2 + 0) * 1024;
    const bf16_t* WRH = (const bf16_t*)(ws + WS_WRH) + (size_t)layer * 64 * 1024; const bf16_t* WRL = (const bf16_t*)(ws + WS_WRL) + (size_t)layer * 64 * 1024;
    const float* rbias = p.router_bias + layer * 64;
    int* IDX = (int*)(ws + WS_IDX); float* WT = (float*)(ws + WS_WT); int* HIST = (int*)(ws + WS_HIST);
    LAS bf16_t* AHI = (LAS bf16_t*)(c.lds + LN_AHI); LAS bf16_t* ALO = (LAS bf16_t*)(c.lds + LN_ALO);
    LAS float* PART = (LAS float*)(c.lds + LN_PART); LAS float* SC = (LAS float*)(c.lds + LN_SC); LAS float* CH = (LAS float*)(c.lds + LN_CH); LAS int* hist = (LAS int*)(c.lds + LN_HIST);
    const int lane = c.lane, r = lane & 31, h = lane >> 5;
    if (c.tid < 64) hist[c.tid] = 0;
    const float rb = rbias[lane]; int myhist = 0;
    const int nt = c.wid & 1, kq = c.wid >> 1;
    bf16x8 bhf[16], blf[16];
    {
        const bf16_t* bh = WRH + (size_t)(nt * 32 + r) * 1024 + kq * 256 + h * 8; const bf16_t* bl = WRL + (size_t)(nt * 32 + r) * 1024 + kq * 256 + h * 8;
#pragma unroll
        for (int ks = 0; ks < 16; ++ks) { bhf[ks] = *(const bf16x8*)(bh + ks * 16); blf[ks] = *(const bf16x8*)(bl + ks * 16); }
    }
    u32x2 raw[4][4];
#define LN_FETCH(T) do { _Pragma("unroll") for (int r4 = 0; r4 < 4; ++r4) _Pragma("unroll") for (int jj = 0; jj < 4; ++jj) \
        raw[r4][jj] = *(const u32x2*)(V + ((size_t)(T) * 32 + c.wid * 4 + r4) * 1024 + jj * 256 + lane * 4); } while (0)
#define LN_SYNC() do { asm volatile("s_waitcnt lgkmcnt(0)" ::: "memory"); __builtin_amdgcn_s_barrier(); asm volatile("" ::: "memory"); } while (0)
    if (c.blk < NLN_TILES) LN_FETCH(c.blk);
    f32x4 gv[4], bv[4];
#pragma unroll
    for (int jj = 0; jj < 4; ++jj) { gv[jj] = *(const f32x4*)(gain + jj * 256 + lane * 4); bv[jj] = *(const f32x4*)(bias + jj * 256 + lane * 4); }
    for (int tile = c.blk; tile < NLN_TILES; tile += c.G) {
        LN_SYNC();
#pragma unroll
        for (int r4 = 0; r4 < 4; ++r4) {
            const int lrow = c.wid * 4 + r4; const size_t row = (size_t)tile * 32 + lrow;
            f32x4 v[4];
            float s = 0.f;
#pragma unroll
            for (int jj = 0; jj < 4; ++jj) { const u32x2 w = raw[r4][jj]; v[jj] = (f32x4){bflo(w.x), bfhi(w.x), bflo(w.y), bfhi(w.y)}; s += v[jj][0] + v[jj][1] + v[jj][2] + v[jj][3]; }
            const float mu = wave_sum(s) * (1.0f / 1024.0f);
            float q = 0.f;
#pragma unroll
            for (int jj = 0; jj < 4; ++jj) { v[jj] = v[jj] - mu; q += v[jj][0] * v[jj][0] + v[jj][1] * v[jj][1] + v[jj][2] * v[jj][2] + v[jj][3] * v[jj][3]; }
            const float rstd = 1.0f / __builtin_sqrtf(wave_sum(q) * (1.0f / 1024.0f) + LN_EPS);
            if (lane == 0) *(f32x2*)(STAT + row * 2) = (f32x2){mu, rstd};
#pragma unroll
            for (int jj = 0; jj < 4; ++jj) {
                const f32x4 y = v[jj] * rstd * gv[jj] + bv[jj];
                const int col = jj * 256 + lane * 4;
                u32x2 hi; hi.x = pk_bf16(y[0], y[1]); hi.y = pk_bf16(y[2], y[3]);
                *(u32x2*)(HB + row * 1024 + col) = hi;
                u32x2 lo; lo.x = pk_bf16(y[0] - bflo(hi.x), y[1] - bfhi(hi.x)); lo.y = pk_bf16(y[2] - bflo(hi.y), y[3] - bfhi(hi.y));
                *(LAS u32x2*)(AHI + lrow * LN_AP + col) = hi; *(LAS u32x2*)(ALO + lrow * LN_AP + col) = lo;
            }
        }
        if (tile + c.G < NLN_TILES) LN_FETCH(tile + c.G);
        LN_SYNC();
        {
            f32x16 acc;
#pragma unroll
            for (int i = 0; i < 16; ++i) acc[i] = 0.f;
            LAS const bf16_t* ah = AHI + r * LN_AP + kq * 256 + h * 8; LAS const bf16_t* al = ALO + r * LN_AP + kq * 256 + h * 8;
#pragma unroll
            for (int ks = 0; ks < 16; ++ks) {
                const bf16x8 a1 = *(const LAS bf16x8*)(ah + ks * 16), a2 = *(const LAS bf16x8*)(al + ks * 16);
                acc = __builtin_amdgcn_mfma_f32_32x32x16_bf16(a1, bhf[ks], acc, 0, 0, 0);
                acc = __builtin_amdgcn_mfma_f32_32x32x16_bf16(a1, blf[ks], acc, 0, 0, 0);
                acc = __builtin_amdgcn_mfma_f32_32x32x16_bf16(a2, bhf[ks], acc, 0, 0, 0);
            }
            LN_SYNC();
#pragma unroll
            for (int i = 0; i < 16; ++i) PART[(kq * 32 + crow(i, h)) * 65 + nt * 32 + r] = acc[i];
        }
        LN_SYNC();
#pragma unroll 1
        for (int rr = 0; rr < 4; ++rr) {
            const int t = c.wid * 4 + rr; const size_t grow = (size_t)tile * 32 + t;
            const float lg = PART[(0 * 32 + t) * 65 + lane] + PART[(1 * 32 + t) * 65 + lane] + PART[(2 * 32 + t) * 65 + lane] + PART[(3 * 32 + t) * 65 + lane];
            const float sc = 1.0f / (1.0f + expf(-lg)), ch = sc + rb;
            float v = ch; int vi = lane;
#define LN_STEP(F) { const float ov = __builtin_bit_cast(float, F(__builtin_bit_cast(int, v))); const int oi = F(vi); if (ov > v || (ov == v && oi < vi)) { v = ov; vi = oi; } }
            LN_STEP(dpp_x1) LN_STEP(dpp_x2) LN_STEP(dpp_hm)
#undef LN_STEP
            float v2 = (lane == vi) ? -INFINITY : ch;
            v2 = fmaxf(v2, __builtin_bit_cast(float, dpp_x1(__builtin_bit_cast(int, v2)))); v2 = fmaxf(v2, __builtin_bit_cast(float, dpp_x2(__builtin_bit_cast(int, v2)))); v2 = fmaxf(v2, __builtin_bit_cast(float, dpp_hm(__builtin_bit_cast(int, v2))));
            const float gs = v + v2; const int g = lane >> 3;
            int gcnt = 0;
#pragma unroll
            for (int g2 = 0; g2 < 8; ++g2) { const float gv = __builtin_bit_cast(float, __builtin_amdgcn_readlane(__builtin_bit_cast(int, gs), g2 * 8)); gcnt += ((gv > gs) || (gv == gs && g2 < g)) ? 1 : 0; }
            const float cv = (gcnt < 4) ? ch : -INFINITY;
            int rank = 0;
            const int cbits = __builtin_bit_cast(int, cv); const int ckey = (cbits >= 0 ? cbits : (int)(0x80000000u - (unsigned)cbits)) & ~63 | (63 - lane);
            {
                const unsigned long long bal = __ballot(gcnt < 4);
                unsigned gm = 0;
#pragma unroll
                for (int g2 = 0; g2 < 8; ++g2) gm |= (unsigned)((bal >> (8 * g2)) & 1ull) << g2;
#pragma unroll 1
                while (gm) { const int gsel = __builtin_ctz(gm); gm &= gm - 1u;
#pragma unroll
                    for (int jj = 0; jj < 8; ++jj) { const int k = 8 * gsel + jj; const int kk2 = __builtin_amdgcn_readlane(ckey, k); rank += (kk2 > ckey) ? 1 : 0; } }
            }
            const bool chosen = (gcnt < 4) && (rank < 8);
            const float wsum = wave_sum(chosen ? sc : 0.f);
            if (chosen) { IDX[grow * 8 + rank] = lane; WT[grow * 8 + rank] = sc * (2.5f / (wsum + 1e-20f)); myhist += 1; }
        }
    }
    __syncthreads();
    __hip_atomic_fetch_add(&hist[lane], myhist, __ATOMIC_RELAXED, __HIP_MEMORY_SCOPE_WORKGROUP);
    __syncthreads();
    if (c.tid < 64) HIST[c.blk * 64 + c.tid] = hist[c.tid];
}
DI void phase_scatter(const Ctx& c) {
    char* ws = (char*)c.kp[23];
    const int* IDX = (const int*)(ws + WS_IDX); const float* WT = (const float*)(ws + WS_WT); const int* HIST = (const int*)(ws + WS_HIST);
    int* INV = (int*)(ws + WS_INV); int* ROWTOK = (int*)(ws + WS_ROWTOK); float* ROWW = (float*)(ws + WS_ROWW); int* TSTART = (int*)(ws + WS_TSTART);
    LAS int* cnt = (LAS int*)(c.lds); LAS int* pre = cnt + 64; LAS int* pst = pre + 64; LAS int* tst = pst + 80; LAS int* cursor = tst + 80;
    __syncthreads();
    {
        LAS int* ps = cursor + 64;
        const int e = c.tid & 63, part = c.tid >> 6, per = (c.G + 7) >> 3;
        int s0 = 0, m0 = 0;
        for (int b = part * per; b < (part + 1) * per && b < c.G; ++b) { const int v = HIST[b * 64 + e]; s0 += v; if (b < c.blk) m0 += v; }
        ps[part * 64 + e] = s0; ps[512 + part * 64 + e] = m0;
        __syncthreads();
        if (c.tid < 64) { int s1 = 0, m1 = 0;
#pragma unroll
            for (int q = 0; q < 8; ++q) { s1 += ps[q * 64 + c.tid]; m1 += ps[512 + q * 64 + c.tid]; }
            cnt[c.tid] = s1; pre[c.tid] = m1; cursor[c.tid] = 0; }
    }
    __syncthreads();
    if (c.tid == 0) { int ps = 0, ts = 0; for (int e = 0; e < 64; ++e) { pst[e] = ps; tst[e] = ts; const int pad = (cnt[e] + 255) & ~255; ps += pad; ts += pad >> 8; } pst[64] = ps; tst[64] = ts; }
    __syncthreads();
    if (c.blk == 0 && c.tid <= 64) TSTART[c.tid] = tst[c.tid];
    for (int e = c.blk; e < 64; e += c.G) { const int start = pst[e] + cnt[e], end = pst[e + 1]; for (int i = start + c.tid; i < end; i += 512) { ROWTOK[i] = ZROW; ROWW[i] = 0.f; } }
    for (int tile = c.blk; tile < NLN_TILES; tile += c.G) {
        if (c.tid < 256) { const size_t a = (size_t)tile * 256 + c.tid; const int e = IDX[a]; const float w = WT[a];
            const int pos = pst[e] + pre[e] + __hip_atomic_fetch_add(&cursor[e], 1, __ATOMIC_RELAXED, __HIP_MEMORY_SCOPE_WORKGROUP);
            ROWTOK[pos] = (int)(a >> 3); ROWW[pos] = w; INV[a] = pos; }
    }
    __syncthreads();
}
DI int build_tile_table(const Ctx& c, LAS int*& tile_e) {
    const int* TSTART = (const int*)((char*)c.kp[23] + WS_TSTART);
    LAS int* tst = (LAS int*)(c.lds + LDS_MISC); tile_e = tst + 80;
    __syncthreads();
    if (c.tid <= 64) tst[c.tid] = TSTART[c.tid];
    __syncthreads();
    const int nrt = __builtin_amdgcn_readfirstlane(tst[64]);
    for (int t = c.tid; t < nrt; t += 512) { int e = 0;
#pragma unroll
        for (int st = 32; st > 0; st >>= 1) e += (tst[e + st] <= t) ? st : 0;
        tile_e[t] = e; }
    __syncthreads();
    return nrt;
}
DI void phase_egu(const Ctx& c, int layer) {
    char* ws = (char*)c.kp[23];
    LAS int* tile_e; const int nrt = build_tile_table(c, tile_e);
    ExpertSched<false> S; S.c = c.blk; S.nrt = nrt; S.tile_e = tile_e; S.ws = ws;
    S.Wr = ws + WS_WEGU + (size_t)layer * 64 * 512 * 1024 * 2; S.Ws = ws + WS_WSGU + (size_t)layer * 512 * 1024 * 2;
    EpiGu E{(bf16_t*)(ws + WS_ACT), (const float*)(ws + WS_ROWW)};
    pg8::gemm_phase(c.lds, c.tid, 1024, 2048u, S, E);
}
#define GAS __attribute__((address_space(1)))
DI void phase_edown3(const Ctx& c, int layer) {
    char* ws = (char*)c.kp[23];
    LAS int* tile_e; const int nrt = build_tile_table(c, tile_e);
    const int ntiles = nrt + N_SH_TILES;
    const GAS bf16_t* ACT = (const GAS bf16_t*)(ws + WS_ACT); GAS unsigned char* Y8 = (GAS unsigned char*)(ws + WS_U);
    const int lane = c.lane, fr = lane & 15, fq = lane >> 4, wid = c.wid;
    unsigned goff[2];
#pragma unroll
    for (int i = 0; i < 2; ++i) { const int p = c.tid + 512 * i, n = p >> 5, kc = (p & 31) ^ (n & 15); goff[i] = (unsigned)(pg8::perm32(n) * 512 + kc * 16); }
    const unsigned ldsw = (unsigned)wid * 1024u;
    LAS unsigned char* ob = c.lds + 65536 + wid * (32 * 160);
#pragma unroll 1
    for (int k = 0;; ++k) {
        const int tile = k * 256 + (c.blk & 7) * 32 + (c.blk >> 3);
        if (tile >= ntiles) break;
        const char* wd; int orow;
        if (tile < nrt) { const int e = __builtin_amdgcn_readfirstlane(tile_e[tile]); orow = tile * 256; wd = ws + WS_WED + ((size_t)layer * 64 + e) * ((size_t)1024 * 256 * 2); }
        else { orow = SH_BASE + (tile - nrt) * 256; wd = ws + WS_WSD + (size_t)layer * 1024 * 256 * 2; }
#define D2_STAGE(slot, J) do { _Pragma("unroll") for (int _h = 0; _h < 2; ++_h) _Pragma("unroll") for (int _i = 0; _i < 2; ++_i) \
        __builtin_amdgcn_global_load_lds((const unsigned*)(wd + (size_t)(2 * (J) + _h) * (32 * 512) + goff[_i]), (LAS unsigned*)(c.lds + (slot) * 32768 + _h * 16384 + ldsw + _i * 8192), 16, 0, 0); } while (0)
        bf16x8 afr[2][8];
#pragma unroll
        for (int mb = 0; mb < 2; ++mb)
#pragma unroll
            for (int ks = 0; ks < 8; ++ks) afr[mb][ks] = *(const GAS bf16x8*)(ACT + (size_t)(orow + 32 * wid + 16 * mb + fr) * 256 + ks * 32 + fq * 8);
        D2_STAGE(0, 0);
        bf16x8 bfr[8][2];
        f32x4 acc[2][2];
#pragma unroll
        for (int mb = 0; mb < 2; ++mb)
#pragma unroll
            for (int nb = 0; nb < 2; ++nb) acc[mb][nb] = (f32x4){0.f, 0.f, 0.f, 0.f};
#define D2_READ(SLOT, H) do { \
        LAS const unsigned char* sb = c.lds + (SLOT) * 32768 + (H) * 16384; \
        _Pragma("unroll") for (int ks = 0; ks < 8; ++ks) _Pragma("unroll") for (int nb = 0; nb < 2; ++nb) bfr[ks][nb] = *(const LAS bf16x8*)(sb + ((16 * nb + fr) * 32 + ((4 * ks + fq) ^ fr)) * 16); } while (0)
#define D2_MMA() do { \
        asm volatile("s_waitcnt lgkmcnt(0)" ::: "memory"); __builtin_amdgcn_sched_barrier(0); __builtin_amdgcn_s_setprio(1); \
        _Pragma("unroll") for (int ks = 0; ks < 8; ++ks) _Pragma("unroll") for (int mb = 0; mb < 2; ++mb) _Pragma("unroll") for (int nb = 0; nb < 2; ++nb) \
            acc[mb][nb] = __builtin_amdgcn_mfma_f32_16x16x32_bf16(bfr[ks][nb], afr[mb][ks], acc[mb][nb], 0, 0, 0); \
        __builtin_amdgcn_s_setprio(0); __builtin_amdgcn_sched_barrier(0); } while (0)
#define D2_EPI(H, PAR) do { \
        _Pragma("unroll") for (int mb = 0; mb < 2; ++mb) { \
              \
            const float am = fmaxf(fmaxf(fmaxf(__builtin_fabsf(acc[mb][0][0]), __builtin_fabsf(acc[mb][0][1])), fmaxf(__builtin_fabsf(acc[mb][0][2]), __builtin_fabsf(acc[mb][0][3]))), \
                                   fmaxf(fmaxf(__builtin_fabsf(acc[mb][1][0]), __builtin_fabsf(acc[mb][1][1])), fmaxf(__builtin_fabsf(acc[mb][1][2]), __builtin_fabsf(acc[mb][1][3])))); \
            const unsigned eb = ((__float_as_uint(am * (1.0f / 127.0f)) >> 23) & 0xffu) + 1u;        \
            const float inv = __uint_as_float((254u - eb) << 23); \
            unsigned q0 = 0, q1 = 0; \
            q0 = __builtin_amdgcn_cvt_pk_u8_f32(__builtin_fmaf(acc[mb][0][0], inv, 128.0f), 0, q0); q0 = __builtin_amdgcn_cvt_pk_u8_f32(__builtin_fmaf(acc[mb][0][1], inv, 128.0f), 1, q0); \
            q0 = __builtin_amdgcn_cvt_pk_u8_f32(__builtin_fmaf(acc[mb][0][2], inv, 128.0f), 2, q0); q0 = __builtin_amdgcn_cvt_pk_u8_f32(__builtin_fmaf(acc[mb][0][3], inv, 128.0f), 3, q0); \
            q1 = __builtin_amdgcn_cvt_pk_u8_f32(__builtin_fmaf(acc[mb][1][0], inv, 128.0f), 0, q1); q1 = __builtin_amdgcn_cvt_pk_u8_f32(__builtin_fmaf(acc[mb][1][1], inv, 128.0f), 1, q1); \
            q1 = __builtin_amdgcn_cvt_pk_u8_f32(__builtin_fmaf(acc[mb][1][2], inv, 128.0f), 2, q1); q1 = __builtin_amdgcn_cvt_pk_u8_f32(__builtin_fmaf(acc[mb][1][3], inv, 128.0f), 3, q1); \
            *(LAS u32x2*)(ob + (16 * mb + fr) * 160 + PAR * 64 + (H) * 32 + 8 * fq) = (u32x2){q0, q1}; \
            *(LAS unsigned char*)(ob + (16 * mb + fr) * 160 + 128 + (PAR * 2 + (H)) * 4 + fq) = (unsigned char)eb; \
            acc[mb][0] = (f32x4){0.f, 0.f, 0.f, 0.f}; acc[mb][1] = (f32x4){0.f, 0.f, 0.f, 0.f}; \
        } } while (0)
#define D2_EPI2(H, PAR) do { \
        _Pragma("unroll") for (int mb = 0; mb < 2; ++mb) { \
              \
            const float am = fmaxf(fmaxf(fmaxf(__builtin_fabsf(acc2[mb][0][0]), __builtin_fabsf(acc2[mb][0][1])), fmaxf(__builtin_fabsf(acc2[mb][0][2]), __builtin_fabsf(acc2[mb][0][3]))), \
                                   fmaxf(fmaxf(__builtin_fabsf(acc2[mb][1][0]), __builtin_fabsf(acc2[mb][1][1])), fmaxf(__builtin_fabsf(acc2[mb][1][2]), __builtin_fabsf(acc2[mb][1][3])))); \
            const unsigned eb = ((__float_as_uint(am * (1.0f / 127.0f)) >> 23) & 0xffu) + 1u;        \
            const float inv = __uint_as_float((254u - eb) << 23); \
            unsigned q0 = 0, q1 = 0; \
            q0 = __builtin_amdgcn_cvt_pk_u8_f32(__builtin_fmaf(acc2[mb][0][0], inv, 128.0f), 0, q0); q0 = __builtin_amdgcn_cvt_pk_u8_f32(__builtin_fmaf(acc2[mb][0][1], inv, 128.0f), 1, q0); \
            q0 = __builtin_amdgcn_cvt_pk_u8_f32(__builtin_fmaf(acc2[mb][0][2], inv, 128.0f), 2, q0); q0 = __builtin_amdgcn_cvt_pk_u8_f32(__builtin_fmaf(acc2[mb][0][3], inv, 128.0f), 3, q0); \
            q1 = __builtin_amdgcn_cvt_pk_u8_f32(__builtin_fmaf(acc2[mb][1][0], inv, 128.0f), 0, q1); q1 = __builtin_amdgcn_cvt_pk_u8_f32(__builtin_fmaf(acc2[mb][1][1], inv, 128.0f), 1, q1); \
            q1 = __builtin_amdgcn_cvt_pk_u8_f32(__builtin_fmaf(acc2[mb][1][2], inv, 128.0f), 2, q1); q1 = __builtin_amdgcn_cvt_pk_u8_f32(__builtin_fmaf(acc2[mb][1][3], inv, 128.0f), 3, q1); \
            *(LAS u32x2*)(ob + (16 * mb + fr) * 160 + PAR * 64 + (H) * 32 + 8 * fq) = (u32x2){q0, q1}; \
            *(LAS unsigned char*)(ob + (16 * mb + fr) * 160 + 128 + (PAR * 2 + (H)) * 4 + fq) = (unsigned char)eb; \
        } } while (0)
#define D2_BODY(SLOT, J, NW) do { \
        asm volatile("s_waitcnt vmcnt(%0)" :: "n"(NW) : "memory"); \
        __builtin_amdgcn_s_barrier(); \
        if ((J) + 1 < 16) D2_STAGE(1 - (SLOT), (J) + 1); \
        D2_READ(SLOT, 0); D2_MMA(); \
        f32x4 acc2[2][2]; _Pragma("unroll") for (int mb = 0; mb < 2; ++mb) _Pragma("unroll") for (int nb = 0; nb < 2; ++nb) { acc2[mb][nb] = acc[mb][nb]; acc[mb][nb] = (f32x4){0.f, 0.f, 0.f, 0.f}; } \
        D2_READ(SLOT, 1);        \
        D2_EPI2(0, (SLOT)); \
        D2_MMA(); \
        D2_EPI(1, (SLOT)); \
        if ((SLOT) == 1) {      \
            _Pragma("unroll") for (int i = 0; i < 4; ++i) { const int q = lane + 64 * i, rr = q >> 3, c16 = q & 7; \
                const u32x4 w = *(const LAS u32x4*)(ob + rr * 160 + c16 * 16); \
                *(GAS u32x4*)(Y8 + (size_t)(orow + 32 * wid + rr) * Y8P + ((J) >> 1) * 128 + c16 * 16) = w; } \
            if (lane < 32) { const u32x4 w = *(const LAS u32x4*)(ob + lane * 160 + 128); \
                *(GAS u32x4*)(Y8 + (size_t)(orow + 32 * wid + lane) * Y8P + 1024 + ((J) >> 1) * 16) = w; } \
        } } while (0)
        D2_BODY(0, 0, 0); D2_BODY(1, 1, 0);
#pragma unroll 1
        for (int J = 2; J < 16; J += 2) { D2_BODY(0, J, 5); D2_BODY(1, J + 1, 0); }
        asm volatile("s_waitcnt vmcnt(0)" ::: "memory");
        __syncthreads();
#undef D2_BODY
#undef D2_READ
#undef D2_MMA
#undef D2_EPI
#undef D2_EPI2
#undef D2_STAGE
    }
}
DI void phase_cln(const Ctx& c, int layer) {
    const Params p = load_params(c.kp); char* ws = p.ws;
    bf16_t* HLO = (bf16_t*)(ws + WS_H); bf16_t* HB = (bf16_t*)(ws + WS_HB); const unsigned char* Y8 = (const unsigned char*)(ws + WS_U); const int* INV = (const int*)(ws + WS_INV);
    const float* gain = p.ln_gain + (layer * 2 + 1) * 1024; const float* bias = p.ln_bias + (layer * 2 + 1) * 1024;
    const bf16_t* V = (const bf16_t*)(ws + WS_V); const float* STAT = (const float*)(ws + WS_STAT);
    const float* gain1 = p.ln_gain + (layer * 2 + 0) * 1024; const float* bias1 = p.ln_bias + (layer * 2 + 0) * 1024;
    const bool last = layer == 3; const int lane = c.lane, c0 = lane * 8;
    f32x4 gv[4], bv[4], g1[4], b1[4];
#pragma unroll
    for (int s = 0; s < 2; ++s)
#pragma unroll
        for (int q = 0; q < 2; ++q) { gv[s * 2 + q] = *(const f32x4*)(gain + s * 512 + c0 + q * 4); bv[s * 2 + q] = *(const f32x4*)(bias + s * 512 + c0 + q * 4);
            g1[s * 2 + q] = *(const f32x4*)(gain1 + s * 512 + c0 + q * 4) * ALPHA; b1[s * 2 + q] = *(const f32x4*)(bias1 + s * 512 + c0 + q * 4) * ALPHA; }
    const int nrows = last ? MR : NR;
    const int stride = c.G * 8;
    int row0 = c.blk * 8 + c.wid;
    int pA = 0, pB = 0;
    { const int rA = row0 < nrows ? row0 : 0, rB = row0 + stride < nrows ? row0 + stride : 0;
      pA = (lane < 8) ? INV[(size_t)rA * 8 + lane] : (SH_BASE + rA); pB = (lane < 8) ? INV[(size_t)rB * 8 + lane] : (SH_BASE + rB); }
    for (; row0 < nrows; row0 += 2 * stride) {
        const int rows2[2] = {row0, row0 + stride};
        const int myp[2] = {pA, pB};
        { const int nA = row0 + 2 * stride, nB = row0 + 3 * stride; const int rA = nA < nrows ? nA : 0, rB = nB < nrows ? nB : 0;
          pA = (lane < 8) ? INV[(size_t)rA * 8 + lane] : (SH_BASE + rA); pB = (lane < 8) ? INV[(size_t)rB * 8 + lane] : (SH_BASE + rB); }
        f32x4 a[2][4];
#pragma unroll
        for (int t = 0; t < 2; ++t) { const int row = rows2[t] < nrows ? rows2[t] : 0;
            const f32x2 st = *(const f32x2*)(STAT + (size_t)row * 2);
#pragma unroll
            for (int s2 = 0; s2 < 2; ++s2) { const u32x4 w = *(const u32x4*)(V + (size_t)row * 1024 + s2 * 512 + c0);
                a[t][s2 * 2] = ((f32x4){bflo(w.x), bfhi(w.x), bflo(w.y), bfhi(w.y)} - st[0]) * st[1] * g1[s2 * 2] + b1[s2 * 2];
                a[t][s2 * 2 + 1] = ((f32x4){bflo(w.z), bfhi(w.z), bflo(w.w), bfhi(w.w)} - st[0]) * st[1] * g1[s2 * 2 + 1] + b1[s2 * 2 + 1]; } }
        u32x2 yw[2][9][2]; float ysc[2][9][2];
#pragma unroll
        for (int t = 0; t < 2; ++t)
#pragma unroll
            for (int k = 0; k < 9; ++k) { const int pos = __builtin_amdgcn_readlane(myp[t], k); const unsigned char* yr = Y8 + (size_t)pos * Y8P;
#pragma unroll
                for (int s2 = 0; s2 < 2; ++s2) { yw[t][k][s2] = *(const u32x2*)(yr + s2 * 512 + c0); ysc[t][k][s2] = __uint_as_float((unsigned)yr[1024 + s2 * 64 + lane] << 23); } }
#pragma unroll
        for (int t = 0; t < 2; ++t) {
#pragma unroll
            for (int k = 0; k < 9; ++k)
#pragma unroll
                for (int s2 = 0; s2 < 2; ++s2) { const u32x2 w = yw[t][k][s2]; const float sc = ysc[t][k][s2], off = -128.0f * sc;
                    a[t][s2 * 2][0] += (float)(w.x & 0xffu) * sc + off; a[t][s2 * 2][1] += (float)((w.x >> 8) & 0xffu) * sc + off; a[t][s2 * 2][2] += (float)((w.x >> 16) & 0xffu) * sc + off; a[t][s2 * 2][3] += (float)(w.x >> 24) * sc + off;
                    a[t][s2 * 2 + 1][0] += (float)(w.y & 0xffu) * sc + off; a[t][s2 * 2 + 1][1] += (float)((w.y >> 8) & 0xffu) * sc + off; a[t][s2 * 2 + 1][2] += (float)((w.y >> 16) & 0xffu) * sc + off; a[t][s2 * 2 + 1][3] += (float)(w.y >> 24) * sc + off; }
            float sm = 0.f;
#pragma unroll
            for (int i = 0; i < 4; ++i) sm += a[t][i][0] + a[t][i][1] + a[t][i][2] + a[t][i][3];
            const float mu = wave_sum(sm) * (1.0f / 1024.0f);
            float q2 = 0.f;
#pragma unroll
            for (int i = 0; i < 4; ++i) { a[t][i] = a[t][i] - mu; q2 += a[t][i][0] * a[t][i][0] + a[t][i][1] * a[t][i][1] + a[t][i][2] * a[t][i][2] + a[t][i][3] * a[t][i][3]; }
            const float rstd = 1.0f / __builtin_sqrtf(wave_sum(q2) * (1.0f / 1024.0f) + LN_EPS);
            if (rows2[t] < nrows) {
#pragma unroll
                for (int s2 = 0; s2 < 2; ++s2) {
                    const f32x4 y0 = a[t][s2 * 2] * rstd * gv[s2 * 2] + bv[s2 * 2], y1 = a[t][s2 * 2 + 1] * rstd * gv[s2 * 2 + 1] + bv[s2 * 2 + 1];
                    const size_t o = (size_t)rows2[t] * 1024 + s2 * 512 + c0;
                    if (last) { *(f32x4*)(p.out + o) = y0; *(f32x4*)(p.out + o + 4) = y1; }
                    else {
                        u32x4 w; w.x = pk_bf16(y0[0], y0[1]); w.y = pk_bf16(y0[2], y0[3]); w.z = pk_bf16(y1[0], y1[1]); w.w = pk_bf16(y1[2], y1[3]);
                        u32x4 l; l.x = pk_bf16(y0[0] - bflo(w.x), y0[1] - bfhi(w.x)); l.y = pk_bf16(y0[2] - bflo(w.y), y0[3] - bfhi(w.y)); l.z = pk_bf16(y1[0] - bflo(w.z), y1[1] - bfhi(w.z)); l.w = pk_bf16(y1[2] - bflo(w.w), y1[3] - bfhi(w.w));
                        *(u32x4*)(HB + o) = w; *(u32x4*)(HLO + o) = l; }
                }
            }
        }
    }
}

DI Ctx make_ctx(unsigned char* smem) {
    Ctx c; c.kp = (KArgPtr)__builtin_amdgcn_kernarg_segment_ptr(); c.lds = (LAS unsigned char*)smem; c.G = (int)gridDim.x; c.blk = (int)blockIdx.x; c.tid = (int)threadIdx.x; c.wid = __builtin_amdgcn_readfirstlane((int)threadIdx.x >> 6); c.lane = (int)threadIdx.x & 63;
    return c;
}
DI void run_phase(const Ctx& c0, int ph, int arg) {
    Ctx c = c0;
    { int t = (int)threadIdx.x; asm volatile("" : "+v"(t)); c.tid = t; c.lane = t & 63; c.wid = __builtin_amdgcn_readfirstlane(t >> 6);
      KArgPtr k = c0.kp; asm volatile("" : "+s"(k)); c.kp = k;
      int b = c0.blk; asm volatile("" : "+s"(b)); c.blk = b; int g = c0.G; asm volatile("" : "+s"(g)); c.G = g; }
    char* ws = (char*)c.kp[23];
    switch (ph) {
        case 0: phase_prologue(c); break;
        case 1: phase_win(c, arg); break;
        case 2: phase_conv(c, arg); break;
        case 3: phase_gates(c, arg); break;
        case 4: phase_scan1(c); break;
        case 5: phase_scan2(c); break;
        case 6: phase_outproj(c, (const bf16_t*)(ws + WS_U + U_Z), (const bf16_t*)(ws + WS_WOUT) + (size_t)arg * 1024 * 1024, arg == 0); break;
        case 7: phase_qkv(c, arg); break;
        case 8: phase_attn(c, arg); break;
        case 9: phase_outproj(c, (const bf16_t*)(ws + WS_U + U_OB), (const bf16_t*)(ws + WS_WO) + (size_t)arg * 1024 * 1024, false); break;
        case 10: phase_lnr(c, arg); break;
        case 11: phase_scatter(c); break;
        case 12: phase_egu(c, arg); break;
        case 13: phase_edown3(c, arg); break;
        default: phase_cln(c, arg); break;
    }
}
DI void grid_sync(const Ctx& c0, XcdBarrier b) { KArgPtr k = c0.kp; asm volatile("" : "+s"(k)); b.bar = (unsigned*)((char*)k[23] + WS_CTL); unsigned x = b.x; asm volatile("" : "+s"(x)); b.x = x; xcd_barrier(b); }
#ifndef PROBE_REP
#define PROBE_REP 0
#endif
#if PROBE_REP
#define RUN(ph, arg) do { int _n = 1 + ((PROBE_REP >> (ph)) & 1); asm volatile("" : "+s"(_n)); _Pragma("unroll 1") for (int _r = 0; _r < _n; ++_r) run_phase(c, ph, arg); grid_sync(c, bar); } while (0)
#else
#define RUN(ph, arg) do { run_phase(c, ph, arg); grid_sync(c, bar); } while (0)
#endif
__global__ void __launch_bounds__(512, 2) fwd_all(Params p) {
    extern __shared__ __attribute__((aligned(16))) unsigned char smem[];
    const Ctx c = make_ctx(smem);
    volatile LAS unsigned* st = (volatile LAS unsigned*)(c.lds + LDS_BYTES - 16);
    if (c.tid == 0) { st[0] = 0u; st[1] = 0u; st[2] = 0u; st[3] = 0u; }
    __syncthreads();
    const XcdBarrier bar = xcd_barrier_post((unsigned*)((char*)c.kp[23] + WS_CTL), st);
    RUN(0, 0);
#pragma unroll 1
    for (int layer = 0; layer < 4; ++layer) {
        const int j = layer >> 1;
        if ((layer & 1) == 0) {
            RUN(1, j); RUN(3, j);
            RUN(5, 0); RUN(6, j);
        } else {
            RUN(7, j); RUN(8, j); RUN(9, j);
        }
        RUN(10, layer); RUN(11, 0); RUN(12, layer);
        RUN(13, layer); RUN(14, layer);
    }
}

#if !MK_ONE_LAUNCH
template <int PH> __global__ void __launch_bounds__(512, 2) k_phase(Params p, int arg) {
    extern __shared__ __attribute__((aligned(16))) unsigned char smem[];
    const Ctx c = make_ctx(smem);
    run_phase(c, PH, arg);
}

template <int PH> static void launch_phase(const Params& p, int arg, int grid, hipStream_t stream) {
    static bool attr = false;
    if (!attr) { if (hipFuncSetAttribute((const void*)k_phase<PH>, hipFuncAttributeMaxDynamicSharedMemorySize, LDS_BYTES) != hipSuccess) fprintf(stderr, "kernel_launch: hipFuncSetAttribute failed (phase %d)\n", PH); attr = true; }
    hipLaunchKernelGGL(k_phase<PH>, dim3(grid), dim3(512), LDS_BYTES, stream, p, arg);
}
#endif

extern "C" void kernel_launch(void* const* d_in, const int* in_sizes, int n_in, void* d_out, int out_size, void* d_ws, size_t ws_size, hipStream_t stream) {
    if (n_in != 22 || ws_size < WS_END || out_size != MR * D) { fprintf(stderr, "kernel_launch: unexpected arguments (n_in %d, out %d, ws %zu, need %zu)\n", n_in, out_size, ws_size, (size_t)WS_END); return; }
    Params p{};
    p.x = (const float*)d_in[0]; p.meta = (const float*)d_in[1]; p.rg_w_in = (const float*)d_in[2]; p.rg_b_in = (const float*)d_in[3]; p.rg_conv_w = (const float*)d_in[4]; p.rg_conv_b = (const float*)d_in[5];
    p.rg_w_gates = (const float*)d_in[6]; p.rg_b_gates = (const float*)d_in[7]; p.rg_a_param = (const float*)d_in[8]; p.rg_w_out = (const float*)d_in[9]; p.attn_w_qkv = (const float*)d_in[10]; p.attn_sinks = (const float*)d_in[11];
    p.attn_w_o = (const float*)d_in[12]; p.rel_table = (const float*)d_in[13]; p.ln_gain = (const float*)d_in[14]; p.ln_bias = (const float*)d_in[15]; p.router_w = (const float*)d_in[16]; p.router_bias = (const float*)d_in[17];
    p.ex_w_gu = (const float*)d_in[18]; p.ex_w_down = (const float*)d_in[19]; p.sh_w_gu = (const float*)d_in[20]; p.sh_w_down = (const float*)d_in[21];
    p.out = (float*)d_out; p.ws = (char*)d_ws;
    const int grid = 256;
    (void)hipMemsetAsync((char*)d_ws + WS_CTL, 0, 65536, stream);
#if MK_ONE_LAUNCH
    static int ok = 0;
    if (!ok) {
        int dev = 0, cus = 0, per_cu = 0;
        if (hipGetDevice(&dev) != hipSuccess || hipDeviceGetAttribute(&cus, hipDeviceAttributeMultiprocessorCount, dev) != hipSuccess) { fprintf(stderr, "kernel_launch: device query failed\n"); return; }
        if (hipFuncSetAttribute((const void*)fwd_all, hipFuncAttributeMaxDynamicSharedMemorySize, LDS_BYTES) != hipSuccess) { fprintf(stderr, "kernel_launch: hipFuncSetAttribute failed\n"); return; }
        if (hipOccupancyMaxActiveBlocksPerMultiprocessor(&per_cu, (const void*)fwd_all, 512, LDS_BYTES) != hipSuccess || per_cu < 1) { fprintf(stderr, "kernel_launch: occupancy query says %d\n", per_cu); return; }
        if (cus * per_cu < grid) { fprintf(stderr, "kernel_launch: %d CUs x %d < %d workgroups: not resident\n", cus, per_cu, grid); return; }
        ok = 1;
    }
    hipLaunchKernelGGL(fwd_all, dim3(grid), dim3(512), LDS_BYTES, stream, p);
#else
    launch_phase<0>(p, 0, grid, stream);
    for (int layer = 0; layer < 4; ++layer) {
        const int j = layer >> 1;
        if ((layer & 1) == 0) {
            launch_phase<1>(p, j, grid, stream); launch_phase<3>(p, j, grid, stream);
            launch_phase<5>(p, 0, grid, stream); launch_phase<6>(p, j, grid, stream);
        } else {
            launch_phase<7>(p, j, grid, stream); launch_phase<8>(p, j, grid, stream); launch_phase<9>(p, j, grid, stream);
        }
        launch_phase<10>(p, layer, grid, stream); launch_phase<11>(p, 0, grid, stream); launch_phase<12>(p, layer, grid, stream); launch_phase<13>(p, layer, grid, stream); launch_phase<14>(p, layer, grid, stream);
    }
#endif
}
```

```cpp
#include <hip/hip_runtime.h>
#include <cstdio>
#include <cstdint>

#ifndef MK_ONE_LAUNCH
#define MK_ONE_LAUNCH 1
#endif

#define DI __device__ __forceinline__
#define LAS __attribute__((address_space(3)))
typedef unsigned short bf16_t;
typedef short bf16x8 __attribute__((ext_vector_type(8)));
typedef float f32x4 __attribute__((ext_vector_type(4)));
typedef float f32x2 __attribute__((ext_vector_type(2)));
typedef float f32x16 __attribute__((ext_vector_type(16)));
typedef unsigned u32x4 __attribute__((ext_vector_type(4)));
typedef unsigned u32x2 __attribute__((ext_vector_type(2)));

constexpr int D = 1024, NBATCH = 2, SEQ = 16384, NMETA = 16;
constexpr int MR = NBATCH * SEQ;
constexpr int NR = MR + NBATCH * NMETA;
constexpr int ZROW = NR;
constexpr int MPAD = 33024;
constexpr int NEXP = 64, TOPK = 8, DE = 256;
constexpr int RT_MAX = 278784;
constexpr int SH_BASE = RT_MAX;
constexpr int ROWS_ALL = RT_MAX + MPAD;
constexpr int N_SH_TILES = MPAD / 256;
constexpr int NLN_TILES = MR / 32;
constexpr float ALPHA = 1.681792830507429f;
constexpr float LN_EPS = 1e-5f;
constexpr int MAXG = 1024;

constexpr size_t al256(size_t x) { return (x + 255) & ~(size_t)255; }
constexpr size_t WS_CTL = 0;
constexpr size_t WS_IOTA = 65536;
constexpr size_t WS_WIN = al256(WS_IOTA + (size_t)ROWS_ALL * 4);
constexpr size_t WS_WG = WS_WIN + (size_t)2 * 2048 * 1024 * 2;
constexpr size_t WS_WOUT = WS_WG + (size_t)2 * 4 * 512 * 256 * 2;
constexpr size_t WS_WQKV = WS_WOUT + (size_t)2 * 1024 * 1024 * 2;
constexpr size_t WS_WO = WS_WQKV + (size_t)2 * 1536 * 1024 * 2;
constexpr size_t WS_WEGU = WS_WO + (size_t)2 * 1024 * 1024 * 2;
constexpr size_t WS_WED = WS_WEGU + (size_t)4 * 64 * 512 * 1024 * 2;
constexpr size_t WS_WSGU = WS_WED + (size_t)4 * 64 * 1024 * 256 * 2;
constexpr size_t WS_WSD = WS_WSGU + (size_t)4 * 512 * 1024 * 2;
constexpr size_t WS_WRH = WS_WSD + (size_t)4 * 1024 * 256 * 2;
constexpr size_t WS_WRL = WS_WRH + (size_t)4 * 64 * 1024 * 2;
constexpr size_t WS_C8 = WS_WRL + (size_t)4 * 64 * 1024 * 2;
constexpr size_t WS_H = al256(WS_C8 + 2 * 1024 * 4);
constexpr size_t WS_HB = WS_H + (size_t)MPAD * 1024 * 4;
constexpr size_t WS_V = WS_HB + (size_t)MPAD * 1024 * 2;
constexpr size_t WS_U = WS_V + (size_t)MPAD * 1024 * 4;
constexpr int YP = 1088;
constexpr size_t U_BYTES = (size_t)ROWS_ALL * YP * 2;
constexpr int Y8P = 1152;
constexpr size_t ROWB = (size_t)MPAD * 1024 * 2;
constexpr size_t U_YB = 0, U_XR = ROWB, U_XC = 2 * ROWB, U_Z = 3 * ROWB, U_AB = 4 * ROWB;
constexpr size_t U_QB = 0, U_KV = ROWB, U_OB = ROWB + ROWB / 2;
constexpr size_t WS_ACT = WS_U + U_BYTES;
constexpr size_t WS_IDX = WS_ACT + (size_t)ROWS_ALL * 256 * 2;
constexpr size_t WS_WT = al256(WS_IDX + (size_t)NR * 8 * 4);
constexpr size_t WS_INV = al256(WS_WT + (size_t)NR * 8 * 4);
constexpr size_t WS_ROWTOK = al256(WS_INV + (size_t)NR * 8 * 4);
constexpr size_t WS_ROWW = al256(WS_ROWTOK + (size_t)RT_MAX * 4);
constexpr size_t WS_HIST = al256(WS_ROWW + (size_t)RT_MAX * 4);
constexpr size_t WS_TSTART = al256(WS_HIST + (size_t)MAXG * 64 * 4);
constexpr size_t WS_AGG = al256(WS_TSTART + 80 * 4);
constexpr size_t WS_STAT = al256(WS_AGG + (size_t)2 * 64 * 1024 * 8);
constexpr size_t WS_END = al256(WS_STAT + (size_t)MPAD * 8);
static_assert(U_AB + 2 * ROWB <= U_BYTES, "U too small");

struct Params {
    const float* x; const float* meta; const float* rg_w_in; const float* rg_b_in; const float* rg_conv_w; const float* rg_conv_b; const float* rg_w_gates; const float* rg_b_gates;
    const float* rg_a_param; const float* rg_w_out; const float* attn_w_qkv; const float* attn_sinks; const float* attn_w_o; const float* rel_table; const float* ln_gain; const float* ln_bias;
    const float* router_w; const float* router_bias; const float* ex_w_gu; const float* ex_w_down; const float* sh_w_gu; const float* sh_w_down;
    float* out; char* ws;
};

typedef __bf16 bf16x2_t __attribute__((ext_vector_type(2)));
DI unsigned pk_bf16(float lo, float hi) { const f32x2 v = {lo, hi}; return __builtin_bit_cast(unsigned, __builtin_convertvector(v, bf16x2_t)); }
DI bf16_t f2bf(float f) { return (bf16_t)(pk_bf16(f, 0.f) & 0xffffu); }
DI float bf2f(unsigned b) { return __uint_as_float(b << 16); }
DI float bflo(unsigned p) { return __uint_as_float(p << 16); }
DI float bfhi(unsigned p) { return __uint_as_float(p & 0xffff0000u); }
DI void res8(u32x4 hi, u32x4 lo, float (&h)[8]) {
    h[0] = bflo(hi.x) + bflo(lo.x); h[1] = bfhi(hi.x) + bfhi(lo.x); h[2] = bflo(hi.y) + bflo(lo.y); h[3] = bfhi(hi.y) + bfhi(lo.y);
    h[4] = bflo(hi.z) + bflo(lo.z); h[5] = bfhi(hi.z) + bfhi(lo.z); h[6] = bflo(hi.w) + bflo(lo.w); h[7] = bfhi(hi.w) + bfhi(lo.w);
}
DI float sigmoidf_(float x) { return __builtin_amdgcn_rcpf(1.0f + __expf(-x)); }
DI float gelu_tanh(float x) { const float u = 1.5957691216057308f * (x + 0.044715f * x * x * x); return x * sigmoidf_(u); }
DI float silu_mul(float g, float u) { return g * sigmoidf_(g) * u; }
DI void lru_gate(float gx, float ga, float xc, float c8  , float& la, float& bx) {
    const float gate_x = sigmoidf_(gx), gate_a = sigmoidf_(ga);
    la = c8 * gate_a;
    const float a = __expf(la);
    const float x2 = 2.0f * la;
    const float omp = -x2 * (1.0f + x2 * 0.5f * (1.0f + x2 * (1.0f / 3.0f) * (1.0f + x2 * 0.25f * (1.0f + x2 * 0.2f))));
    const float om = (x2 > -0.3f) ? omp : 1.0f - a * a;
    bx = xc * gate_x * __builtin_amdgcn_sqrtf(om);
}
DI int dpp_x1(int v) { return __builtin_amdgcn_mov_dpp(v, 0xB1, 0xF, 0xF, true); }
DI int dpp_x2(int v) { return __builtin_amdgcn_mov_dpp(v, 0x4E, 0xF, 0xF, true); }
DI int dpp_hm(int v) { return __builtin_amdgcn_mov_dpp(v, 0x141, 0xF, 0xF, true); }
DI float xor32(float x) {
    const auto r = __builtin_amdgcn_permlane32_swap(__builtin_bit_cast(unsigned, x), __builtin_bit_cast(unsigned, x), false, false);
    return __builtin_bit_cast(float, (threadIdx.x & 32) ? r[0] : r[1]);
}
DI float wave_sum(float v) {
    v += __builtin_bit_cast(float, __builtin_amdgcn_mov_dpp(__builtin_bit_cast(int, v), 0xB1, 0xF, 0xF, true));
    v += __builtin_bit_cast(float, __builtin_amdgcn_mov_dpp(__builtin_bit_cast(int, v), 0x4E, 0xF, 0xF, true));
    v += __builtin_bit_cast(float, __builtin_amdgcn_mov_dpp(__builtin_bit_cast(int, v), 0x141, 0xF, 0xF, true));
    v += __builtin_bit_cast(float, __builtin_amdgcn_mov_dpp(__builtin_bit_cast(int, v), 0x140, 0xF, 0xF, true));
    const int b = __builtin_bit_cast(int, v);
    return (__builtin_bit_cast(float, __builtin_amdgcn_readlane(b, 0)) + __builtin_bit_cast(float, __builtin_amdgcn_readlane(b, 16))) + (__builtin_bit_cast(float, __builtin_amdgcn_readlane(b, 32)) + __builtin_bit_cast(float, __builtin_amdgcn_readlane(b, 48)));
}

__device__ const unsigned char kBucket[160] = {
    0, 1, 2, 3, 4, 5, 6, 7, 8, 9, 10, 11, 12, 13, 14, 15, 16, 16, 16, 17, 17, 18, 18, 18, 19, 19, 19, 20, 20, 20, 20, 21, 21, 21, 21, 22, 22, 22, 22, 22, 23, 23, 23, 23, 23, 23, 24, 24, 24, 24, 24, 24,
    25, 25, 25, 25, 25, 25, 25, 26, 26, 26, 26, 26, 26, 26, 26, 27, 27, 27, 27, 27, 27, 27, 27, 27, 27, 28, 28, 28, 28, 28, 28, 28, 28, 28, 28, 29, 29, 29, 29, 29, 29, 29, 29, 29, 29, 29, 29,
    30, 30, 30, 30, 30, 30, 30, 30, 30, 30, 30, 30, 30, 30, 31, 31, 31, 31, 31, 31, 31, 31, 31, 31, 31, 31, 31, 31, 31, 31, 31, 31, 31, 31, 31, 31, 31, 31, 31, 31, 31, 31, 31, 31, 31, 31, 31,
    31, 31, 31, 31, 31, 31, 31, 31, 31, 31, 31, 31, 31, 31};

#define XB_TMO      128
#define XB_XCNT(j)  (256  + 64 * (j))
#define XB_XSUB(j)  (1280 + 64 * (j))
#define XB_XGEN(j)  (2304 + 64 * (j))
#define XB_TOP      3328
#define XB_TOPGEN   3392
#define XCD_BAR_WORDS 3456
#define XB_SPIN_CAP (1u << 22)
DI unsigned xb_ld(unsigned* p)              { return __hip_atomic_load(p, __ATOMIC_RELAXED, __HIP_MEMORY_SCOPE_AGENT); }
DI unsigned xb_add(unsigned* p, unsigned v) { return __hip_atomic_fetch_add(p, v, __ATOMIC_RELAXED, __HIP_MEMORY_SCOPE_AGENT); }
DI unsigned xb_xcc_id() { return (unsigned)__builtin_amdgcn_s_getreg((3 << 11) | 20) & 0xFu; }
#define XB_SPIN(cond, bar) do { unsigned _sp = 0; while (cond) { __builtin_amdgcn_s_sleep(1); \
    if ((++_sp & 255u) == 0u) { if (xb_ld(&(bar)[XB_TMO])) break; if (_sp > XB_SPIN_CAP) { atomicAdd(&(bar)[XB_TMO], 1u); break; } } } } while (0)
struct XcdBarrier { unsigned* bar; unsigned x; volatile LAS unsigned* st; };
DI XcdBarrier xcd_barrier_post(unsigned* bar, volatile LAS unsigned* st) {
    XcdBarrier b; b.bar = bar; b.x = xb_xcc_id(); b.st = st;
    if (threadIdx.x == 0) (void)xb_add(&bar[XB_XCNT(b.x)], 1u);
    return b;
}
DI void xcd_barrier_complete(unsigned* bar, unsigned x, unsigned& nloc, unsigned& nx) {
    const unsigned G = gridDim.x * gridDim.y * gridDim.z;
    unsigned sum, cnt, mine, sp = 0u;
    for (;;) {
        sum = 0u; cnt = 0u; mine = 0u;
#pragma unroll
        for (unsigned j = 0; j < 16; ++j) { const unsigned c = xb_ld(&bar[XB_XCNT(j)]); sum += c; cnt += (c > 0u) ? 1u : 0u; mine = (j == x) ? c : mine; }
        if (sum == G) break;
        __builtin_amdgcn_s_sleep(1);
        if ((++sp & 255u) == 0u) { if (xb_ld(&bar[XB_TMO])) break; if (sp > XB_SPIN_CAP) { atomicAdd(&bar[XB_TMO], 1u); break; } }
    }
    nloc = mine > 0u ? mine : 1u; nx = cnt > 0u ? cnt : 1u;
}
DI void xcd_barrier(const XcdBarrier& b) {
    asm volatile("s_waitcnt vmcnt(0)" ::: "memory");
    __syncthreads();
    if (threadIdx.x == 0) {
        unsigned* bar = b.bar;
        __builtin_amdgcn_s_waitcnt(0);
        unsigned nloc = b.st[0], nx = b.st[1];
        if (nloc == 0u) { xcd_barrier_complete(bar, b.x, nloc, nx); b.st[0] = nloc; b.st[1] = nx; }
        const unsigned old = xb_add(&bar[XB_XSUB(b.x)], 1u);
        const unsigned gen = old / nloc;
        if (old + 1u == (gen + 1u) * nloc) {
            __builtin_amdgcn_fence(__ATOMIC_RELEASE, "agent");
            asm volatile("s_waitcnt vmcnt(0)" ::: "memory");
            const unsigned og = xb_add(&bar[XB_TOP], 1u);
            const unsigned tg = og / nx;
            if (og + 1u == (tg + 1u) * nx) xb_add(&bar[XB_TOPGEN], 1u);
            else XB_SPIN(xb_ld(&bar[XB_TOPGEN]) == tg, bar);
            __builtin_amdgcn_fence(__ATOMIC_ACQUIRE, "agent");
            xb_add(&bar[XB_XGEN(b.x)], 1u);
            asm volatile("s_waitcnt vmcnt(0)" ::: "memory");
        } else {
            XB_SPIN(xb_ld(&bar[XB_XGEN(b.x)]) == gen, bar);
            __builtin_amdgcn_fence(__ATOMIC_ACQUIRE, "agent");
            asm volatile("s_waitcnt vmcnt(0)" ::: "memory");
        }
    }
    __syncthreads();
}

namespace pg8 {
constexpr int BM = 256, BK = 64, HALF = 128, HTB = HALF * BK * 2, STAGE_BYTES = 8 * HTB;
constexpr int IDXT_OFF = STAGE_BYTES + 8192;
__host__ __device__ __forceinline__ int lds_byte(int r, int c) { const int st = (r >> 4) * 2 + (c >> 5), rr = r & 15, cc = c & 31, ob = rr * 64 + cc * 2; return st * 1024 + (ob ^ (((ob >> 9) & 1) << 5)); }
__host__ __device__ __forceinline__ void stage_rc(int b, int& R, int& C) { const int st = b / 1024, sb = b % 1024, swz = sb ^ (((sb >> 9) & 1) << 5); R = (st >> 1) * 16 + swz / 64; C = (st & 1) * 32 + (swz % 64) / 2; }
__host__ __device__ __forceinline__ int perm32(int rho) { const int n = rho >> 4, i = rho & 15; return 8 * (i >> 2) + 4 * n + (i & 3); }

struct Unit { const char* A; const int* rows; const char* Bt; int arow; int orow; int pn; int aux; };

template <class Epi, class Sched>
DI void gemm_phase(LAS unsigned char* lds, const int tid, const int K, const unsigned lda_bytes, const Sched& S, const Epi& E) {
    const int wid = __builtin_amdgcn_readfirstlane(tid >> 6), lane = tid & 63, wr = wid >> 2, wc = wid & 3, fr = lane & 15, fq = lane >> 4;
    const int nt = K / BK;
    unsigned voffB[2], cofA[2]; int rsel[2];
#pragma unroll
    for (int i = 0; i < 2; ++i) { int R, C; stage_rc(tid * 16 + i * 8192, R, C); const int Rb = Epi::PERM ? ((R & ~31) + perm32(R & 31)) : R;
        voffB[i] = (unsigned)(Rb * K + C) * 2u; cofA[i] = (unsigned)C * 2u; rsel[i] = R; }
    const size_t kstep = (size_t)(BK * 2);
    const size_t hstep = (size_t)HALF * K * 2;
    const unsigned ldsw = (unsigned)wid * 1024u;
    const int aoff = lds_byte(wr * 64 + fr, fq * 8), boff = lds_byte(wc * 32 + fr, fq * 8);
#define PG8_SA(b, h) (((b) * 2 + (h)) * HTB)
#define PG8_SB(b, h) ((4 + (b) * 2 + (h)) * HTB)
#define PG8_STAGE(bufoff, gbase, voff) do { _Pragma("unroll") for (int _i = 0; _i < 2; ++_i) \
        __builtin_amdgcn_global_load_lds((const unsigned*)((const char*)(gbase) + (voff)[_i]), (LAS unsigned*)(lds + (bufoff) + ldsw + _i * 8192), 16, 0, 0); } while (0)
#define PG8_LDA(dst, b, h) do { _Pragma("unroll") for (int m = 0; m < 4; ++m) _Pragma("unroll") for (int k = 0; k < 2; ++k) dst[m][k] = *(const LAS bf16x8*)(lds + PG8_SA(b, h) + aoff + m * 2048 + k * 1024); } while (0)
#define PG8_LDB(dst, b, h) do { _Pragma("unroll") for (int n = 0; n < 2; ++n) _Pragma("unroll") for (int k = 0; k < 2; ++k) dst[n][k] = *(const LAS bf16x8*)(lds + PG8_SB(b, h) + boff + n * 2048 + k * 1024); } while (0)
#define PG8_MMA(ai, bj, At, Bt) do { __builtin_amdgcn_s_setprio(1); _Pragma("unroll") for (int m = 0; m < 4; ++m) _Pragma("unroll") for (int n = 0; n < 2; ++n) _Pragma("unroll") for (int k = 0; k < 2; ++k) \
        acc[ai][bj][m][n] = __builtin_amdgcn_mfma_f32_16x16x32_bf16(Bt[n][k], At[m][k], acc[ai][bj][m][n], 0, 0, 0); __builtin_amdgcn_s_setprio(0); } while (0)
#define PG8_WAIT_V(n) asm volatile("s_waitcnt vmcnt(" #n ")" ::: "memory")
#define PG8_WAIT_L(n) asm volatile("s_waitcnt lgkmcnt(" #n ")" ::: "memory")
#define PG8_BAR __builtin_amdgcn_s_barrier()
#define PG8_SCHED __builtin_amdgcn_sched_barrier(0)
    Unit cur, nxt; int ui = 0;
    if (!S.next(0, cur)) return;
    f32x4 acc[2][2][4][2];
#pragma unroll
    for (int a = 0; a < 2; ++a)
#pragma unroll
        for (int b = 0; b < 2; ++b)
#pragma unroll
            for (int m = 0; m < 4; ++m)
#pragma unroll
                for (int n = 0; n < 2; ++n) acc[a][b][m][n] = (f32x4){0.f, 0.f, 0.f, 0.f};
    bf16x8 At[4][2], B0[2][2], B1[2][2];
    unsigned vA0[2], vA1[2], o0[2], o1[2];
    LAS int* idxt = (LAS int*)(lds + IDXT_OFF);
#define PG8_IDX_DMA(u, slot) do { if (wid < 4) __builtin_amdgcn_global_load_lds((const unsigned*)((u).rows + wid * 64 + lane), (LAS unsigned*)(idxt + (slot) * 256 + wid * 64), 4, 0, 0); } while (0)
    if constexpr (Sched::GATHER) {
        PG8_IDX_DMA(cur, 0);
        asm volatile("s_waitcnt vmcnt(0)" ::: "memory"); __builtin_amdgcn_s_barrier();
#pragma unroll
        for (int i = 0; i < 2; ++i) { vA0[i] = (unsigned)idxt[rsel[i]] * lda_bytes + cofA[i]; vA1[i] = (unsigned)idxt[HALF + rsel[i]] * lda_bytes + cofA[i]; }
    } else {
#pragma unroll
        for (int i = 0; i < 2; ++i) { vA0[i] = (unsigned)(cur.arow + rsel[i]) * lda_bytes + cofA[i]; vA1[i] = vA0[i] + (unsigned)HALF * lda_bytes; }
    }
    const char* cA = cur.A; const char* cB = cur.Bt;
    PG8_STAGE(PG8_SB(0, 0), cB, voffB); PG8_STAGE(PG8_SB(0, 1), cB + hstep, voffB); PG8_STAGE(PG8_SA(0, 0), cA, vA0); PG8_STAGE(PG8_SA(0, 1), cA, vA1);
    if (wr == 1) PG8_BAR;
    PG8_WAIT_V(2); PG8_BAR;
    PG8_STAGE(PG8_SB(1, 0), cB + kstep, voffB); PG8_STAGE(PG8_SA(1, 0), cA + kstep, vA0); PG8_STAGE(PG8_SB(1, 1), cB + hstep + kstep, voffB);
    PG8_WAIT_V(6); PG8_BAR;
#pragma unroll 1
    for (;;) {
        const bool has_next = S.next(ui + 1, nxt);
        const char* nA = has_next ? nxt.A : cA; const char* nB = has_next ? nxt.Bt : cB;
        if constexpr (Sched::GATHER) { if (has_next) PG8_IDX_DMA(nxt, (ui + 1) & 1); }
#pragma unroll 1
        for (int t = 0; t < nt; t += 2) {
            const bool last = (t == nt - 2);
            const char* a1 = cA + (size_t)(t + 1) * kstep;
            const char* a2 = last ? nA : cA + (size_t)(t + 2) * kstep; const char* b2 = last ? nB : cB + (size_t)(t + 2) * kstep;
            const char* a3 = a2 + kstep; const char* b3 = b2 + kstep;
#pragma unroll
            for (int i = 0; i < 2; ++i) { o0[i] = vA0[i]; o1[i] = vA1[i]; }
            if (last && has_next) {
                if constexpr (Sched::GATHER) {
#pragma unroll
                    for (int i = 0; i < 2; ++i) { o0[i] = (unsigned)idxt[((ui + 1) & 1) * 256 + rsel[i]] * lda_bytes + cofA[i]; o1[i] = (unsigned)idxt[((ui + 1) & 1) * 256 + HALF + rsel[i]] * lda_bytes + cofA[i]; }
                } else {
#pragma unroll
                    for (int i = 0; i < 2; ++i) { o0[i] = (unsigned)(nxt.arow + rsel[i]) * lda_bytes + cofA[i]; o1[i] = o0[i] + (unsigned)HALF * lda_bytes; }
                }
            }
            PG8_LDB(B0, 0, 0); PG8_LDB(B1, 0, 1); PG8_SCHED; PG8_LDA(At, 0, 0); PG8_STAGE(PG8_SA(1, 1), a1, vA1);
            PG8_WAIT_V(8); PG8_WAIT_L(0); PG8_BAR; PG8_MMA(0, 0, At, B0); PG8_MMA(0, 1, At, B1); PG8_BAR; PG8_SCHED;
            PG8_LDA(At, 0, 1); PG8_STAGE(PG8_SB(0, 0), b2, voffB); PG8_STAGE(PG8_SB(0, 1), b2 + hstep, voffB); PG8_STAGE(PG8_SA(0, 0), a2, o0);
            PG8_WAIT_V(8); PG8_WAIT_L(0); PG8_BAR; PG8_MMA(1, 0, At, B0); PG8_MMA(1, 1, At, B1); PG8_BAR; PG8_SCHED;
            PG8_LDB(B0, 1, 0); PG8_LDB(B1, 1, 1); PG8_SCHED; PG8_LDA(At, 1, 0); PG8_STAGE(PG8_SA(0, 1), a2, o1);
            PG8_WAIT_V(8); PG8_WAIT_L(0); PG8_BAR; PG8_MMA(0, 0, At, B0); PG8_MMA(0, 1, At, B1); PG8_BAR; PG8_SCHED;
            PG8_LDA(At, 1, 1); PG8_STAGE(PG8_SB(1, 0), b3, voffB); PG8_STAGE(PG8_SB(1, 1), b3 + hstep, voffB); PG8_STAGE(PG8_SA(1, 0), a3, o0);
            PG8_WAIT_V(8); PG8_WAIT_L(0); PG8_BAR; PG8_MMA(1, 0, At, B0); PG8_MMA(1, 1, At, B1); PG8_BAR; PG8_SCHED;
        }
        if (wr == 0) PG8_BAR;
        E(acc, cur, wr, wc, fr, fq);
        if (!has_next) break;
#pragma unroll
        for (int a = 0; a < 2; ++a)
#pragma unroll
            for (int b = 0; b < 2; ++b)
#pragma unroll
                for (int m = 0; m < 4; ++m)
#pragma unroll
                    for (int n = 0; n < 2; ++n) acc[a][b][m][n] = (f32x4){0.f, 0.f, 0.f, 0.f};
        cur = nxt; cA = nA; cB = nB; ++ui;
#pragma unroll
        for (int i = 0; i < 2; ++i) { vA0[i] = o0[i]; vA1[i] = o1[i]; }
        if (wr == 1) PG8_BAR;
    }
    PG8_WAIT_V(0);
    PG8_BAR;
#undef PG8_IDX_DMA
#undef PG8_SA
#undef PG8_SB
#undef PG8_STAGE
#undef PG8_LDA
#undef PG8_LDB
#undef PG8_MMA
#undef PG8_WAIT_V
#undef PG8_WAIT_L
#undef PG8_BAR
#undef PG8_SCHED
}
}
using pg8::Unit;

DI int crow(int reg, int h) { return (reg & 3) + 8 * (reg >> 2) + 4 * h; }
template <int KW> DI void block_gemm32(LAS unsigned char* lds, const char* Ap, size_t lda, const char* Bp, size_t ldb, int wid, int lane, float (&x2)[2]) {
    const int r = lane & 31, h = lane >> 5;
    const char* a = Ap + (size_t)r * lda + (size_t)wid * KW * 2 + h * 16; const char* b = Bp + (size_t)r * ldb + (size_t)wid * KW * 2 + h * 16;
    bf16x8 av[KW / 16], bv[KW / 16];
#pragma unroll
    for (int s = 0; s < KW / 16; ++s) { av[s] = *(const bf16x8*)(a + s * 32); bv[s] = *(const bf16x8*)(b + s * 32); }
    f32x16 acc;
#pragma unroll
    for (int i = 0; i < 16; ++i) acc[i] = 0.f;
#pragma unroll
    for (int s = 0; s < KW / 16; ++s) acc = __builtin_amdgcn_mfma_f32_32x32x16_bf16(av[s], bv[s], acc, 0, 0, 0);
    LAS float* P = (LAS float*)lds;
#pragma unroll
    for (int i = 0; i < 16; ++i) P[(wid * 16 + i) * 64 + lane] = acc[i];
    __syncthreads();
#pragma unroll
    for (int ii = 0; ii < 2; ++ii) { float sum = 0.f;
#pragma unroll
        for (int p = 0; p < 8; ++p) sum += P[(p * 16 + 2 * wid + ii) * 64 + lane];
        x2[ii] = sum; }
    __syncthreads();
}

struct DenseSched {
    static constexpr bool GATHER = false;
    int nM, nN, nwg, G, c; const char* A; const int* iota; const char* Bt; int K; bool gates;
    DI void init(int nN_, int G_, int c_, const char* A_, const int* iota_, const char* Bt_, int K_, bool gates_) { nM = MR / 256; nN = nN_; nwg = nM * nN; G = G_; c = c_; A = A_; iota = iota_; Bt = Bt_; K = K_; gates = gates_; }
    DI bool next(int i, Unit& u) const {
        const long L = (long)i * G + c; if (L >= nwg) return false;
        int wgid = (int)L; { const int q = nwg / 8, r = nwg % 8, xcd = wgid % 8, off = wgid / 8; wgid = (xcd < r ? xcd * (q + 1) : r * (q + 1) + (xcd - r) * q) + off; }
        const int nig = 8 * nN, gid = wgid / nig, fm = gid * 8, gsz = (nM - fm) < 8 ? (nM - fm) : 8;
        const int pm = fm + ((wgid % nig) % gsz), pn = (wgid % nig) / gsz;
        u.A = A + (gates ? (size_t)(pn >> 1) * 512 : (size_t)0); u.rows = nullptr; u.arow = pm * 256; u.Bt = Bt + (size_t)pn * 256 * K * 2; u.orow = pm * 256; u.pn = pn; u.aux = 0;
        return true;
    }
};
template <bool DOWN> struct ExpertSched {
    static constexpr bool GATHER = !DOWN;
    static constexpr int NPN = DOWN ? 4 : 2, K = DOWN ? 256 : 1024, TPX = 32 / NPN, PER_ROUND = 8 * TPX;
    static constexpr size_t WSTRIDE = DOWN ? (size_t)1024 * 256 * 2 : (size_t)512 * 1024 * 2;
    int c, nrt; LAS const int* tile_e; const char* ws; const char* Wr; const char* Ws;
    DI bool next(int i, Unit& u) const {
        const int x = c & 7, s = c >> 3;
        const int tile = i * PER_ROUND + x * TPX + s / NPN, pn = s % NPN;
        if (tile >= nrt + N_SH_TILES) return false;
        u.A = ws + (DOWN ? WS_ACT : WS_HB); u.pn = pn;
        const int* iota = (const int*)(ws + WS_IOTA);
        if (tile < nrt) { const int e = __builtin_amdgcn_readfirstlane(tile_e[tile]); u.aux = e; u.orow = tile * 256; u.arow = u.orow; u.rows = DOWN ? nullptr : (const int*)(ws + WS_ROWTOK) + tile * 256; u.Bt = Wr + (size_t)e * WSTRIDE + (size_t)pn * 256 * K * 2; }
        else { const int t2 = tile - nrt; u.aux = -1; u.orow = SH_BASE + t2 * 256; u.arow = u.orow; u.rows = DOWN ? nullptr : iota + t2 * 256; u.Bt = Ws + (size_t)pn * 256 * K * 2; }
        return true;
    }
};

struct EpiWin {
    static constexpr bool PERM = true;
    bf16_t* YB; bf16_t* XR; const float* bias;
    DI void operator()(const f32x4 (&acc)[2][2][4][2], const Unit& u, int wr, int wc, int fr, int fq) const {
        const bool isy = u.pn < 4; bf16_t* base = isy ? YB : XR;
        const int colo = (isy ? u.pn : u.pn - 4) * 256 + wc * 32 + 8 * fq, bcol = u.pn * 256 + wc * 32 + 8 * fq;
        f32x4 bv[2][2];
#pragma unroll
        for (int bj = 0; bj < 2; ++bj)
#pragma unroll
            for (int n = 0; n < 2; ++n) bv[bj][n] = *(const f32x4*)(bias + bcol + bj * 128 + 4 * n);
#pragma unroll
        for (int ai = 0; ai < 2; ++ai)
#pragma unroll
            for (int m = 0; m < 4; ++m) { bf16_t* rowp = base + (size_t)(u.orow + ai * 128 + wr * 64 + m * 16 + fr) * 1024 + colo;
#pragma unroll
                for (int bj = 0; bj < 2; ++bj) { f32x4 v0 = acc[ai][bj][m][0] + bv[bj][0], v1 = acc[ai][bj][m][1] + bv[bj][1];
                    if (isy) {
#pragma unroll
                        for (int j = 0; j < 4; ++j) { v0[j] = gelu_tanh(v0[j]); v1[j] = gelu_tanh(v1[j]); } }
                    u32x4 w; w.x = pk_bf16(v0[0], v0[1]); w.y = pk_bf16(v0[2], v0[3]); w.z = pk_bf16(v1[0], v1[1]); w.w = pk_bf16(v1[2], v1[3]);
                    *(u32x4*)(rowp + bj * 128) = w; } }
    }
};
struct EpiGates {
    static constexpr bool PERM = false;
    unsigned* AB; const bf16_t* XC; const float* bg; const float* c8;
    DI void operator()(const f32x4 (&acc)[2][2][4][2], const Unit& u, int wr, int wc, int fr, int fq) const {
        const int nb = u.pn >> 1, ph = u.pn & 1;
#pragma unroll
        for (int n = 0; n < 2; ++n) {
            const int cl = ph * 128 + wc * 32 + 16 * n + 4 * fq;
            const int ch = nb * 256 + cl;
            const f32x4 bgx = *(const f32x4*)(bg + nb * 512 + cl), bga = *(const f32x4*)(bg + nb * 512 + 256 + cl), cc = *(const f32x4*)(c8 + ch);
            u32x2 xpv[2][4];
#pragma unroll
            for (int ai = 0; ai < 2; ++ai)
#pragma unroll
                for (int m = 0; m < 4; ++m) xpv[ai][m] = *(const u32x2*)(XC + (size_t)(u.orow + ai * 128 + wr * 64 + m * 16 + fr) * 1024 + ch);
            asm volatile("" ::: "memory");
#pragma unroll
            for (int ai = 0; ai < 2; ++ai)
#pragma unroll
                for (int m = 0; m < 4; ++m) {
                    const size_t row = (size_t)(u.orow + ai * 128 + wr * 64 + m * 16 + fr);
                    const u32x2 xp = xpv[ai][m];
                    const float xc[4] = {bflo(xp.x), bfhi(xp.x), bflo(xp.y), bfhi(xp.y)};
                    u32x4 w4;
#pragma unroll
                    for (int j = 0; j < 4; ++j) { float a, b; lru_gate(acc[ai][0][m][n][j] + bgx[j], acc[ai][1][m][n][j] + bga[j], xc[j], cc[j], a, b); w4[j] = pk_bf16(a, b); }
                    *(u32x4*)(AB + row * 1024 + ch) = w4;
                    asm volatile("" ::: "memory");
                }
        }
    }
};
struct EpiResid {
    static constexpr bool PERM = true;
    bf16_t* V; const float* x; const bf16_t* HB; const bf16_t* HLO;
    DI void operator()(const f32x4 (&acc)[2][2][4][2], const Unit& u, int wr, int wc, int fr, int fq) const {
        const int col0 = u.pn * 256 + wc * 32 + 8 * fq;
#pragma unroll
        for (int ai = 0; ai < 2; ++ai)
#pragma unroll
            for (int m = 0; m < 4; ++m) { const size_t ro = (size_t)(u.orow + ai * 128 + wr * 64 + m * 16 + fr) * 1024 + col0;
#pragma unroll
                for (int bj = 0; bj < 2; ++bj) {
                    float h[8];
                    if (x) { const f32x4 h0 = *(const f32x4*)(x + ro + bj * 128), h1 = *(const f32x4*)(x + ro + bj * 128 + 4); h[0] = h0[0]; h[1] = h0[1]; h[2] = h0[2]; h[3] = h0[3]; h[4] = h1[0]; h[5] = h1[1]; h[6] = h1[2]; h[7] = h1[3]; }
                    else res8(*(const u32x4*)(HB + ro + bj * 128), *(const u32x4*)(HLO + ro + bj * 128), h);
                    const f32x4 a0 = acc[ai][bj][m][0], a1 = acc[ai][bj][m][1];
                    u32x4 w; w.x = pk_bf16(h[0] * ALPHA + a0[0], h[1] * ALPHA + a0[1]); w.y = pk_bf16(h[2] * ALPHA + a0[2], h[3] * ALPHA + a0[3]);
                    w.z = pk_bf16(h[4] * ALPHA + a1[0], h[5] * ALPHA + a1[1]); w.w = pk_bf16(h[6] * ALPHA + a1[2], h[7] * ALPHA + a1[3]);
                    *(u32x4*)(V + ro + bj * 128) = w; } }
    }
};
struct EpiQkv {
    static constexpr bool PERM = true;
    bf16_t* Q; bf16_t* KV;
    DI void operator()(const f32x4 (&acc)[2][2][4][2], const Unit& u, int wr, int wc, int fr, int fq) const {
        const bool isq = u.pn < 4; bf16_t* base = isq ? Q : KV; const int ld = isq ? 1024 : 512;
        const int col0 = (isq ? u.pn : u.pn - 4) * 256 + wc * 32 + 8 * fq;
#pragma unroll
        for (int ai = 0; ai < 2; ++ai)
#pragma unroll
            for (int m = 0; m < 4; ++m) { bf16_t* rowp = base + (size_t)(u.orow + ai * 128 + wr * 64 + m * 16 + fr) * ld + col0;
#pragma unroll
                for (int bj = 0; bj < 2; ++bj) { const f32x4 v0 = acc[ai][bj][m][0], v1 = acc[ai][bj][m][1];
                    u32x4 w; w.x = pk_bf16(v0[0], v0[1]); w.y = pk_bf16(v0[2], v0[3]); w.z = pk_bf16(v1[0], v1[1]); w.w = pk_bf16(v1[2], v1[3]);
                    *(u32x4*)(rowp + bj * 128) = w; } }
    }
};
struct EpiGu {
    static constexpr bool PERM = true;
    bf16_t* ACT; const float* roww;
    DI void operator()(const f32x4 (&acc)[2][2][4][2], const Unit& u, int wr, int wc, int fr, int fq) const {
        const int col0 = u.pn * 128 + wc * 32 + 8 * fq;
        float w8[2][4];
#pragma unroll
        for (int ai = 0; ai < 2; ++ai)
#pragma unroll
            for (int m = 0; m < 4; ++m) w8[ai][m] = (u.aux >= 0) ? roww[u.orow + ai * 128 + wr * 64 + m * 16 + fr] : 1.0f;
#pragma unroll
        for (int ai = 0; ai < 2; ++ai)
#pragma unroll
            for (int m = 0; m < 4; ++m) { const int row = u.orow + ai * 128 + wr * 64 + m * 16 + fr;
                bf16_t* rowp = ACT + (size_t)row * 256 + col0;
                float v[8];
#pragma unroll
                for (int n = 0; n < 2; ++n)
#pragma unroll
                    for (int j = 0; j < 4; ++j) v[n * 4 + j] = silu_mul(acc[ai][0][m][n][j], acc[ai][1][m][n][j]) * w8[ai][m];
                u32x4 w; w.x = pk_bf16(v[0], v[1]); w.y = pk_bf16(v[2], v[3]); w.z = pk_bf16(v[4], v[5]); w.w = pk_bf16(v[6], v[7]);
                *(u32x4*)rowp = w; }
    }
};

constexpr int LDS_MISC = pg8::STAGE_BYTES;
constexpr int LDS_BYTES = LDS_MISC + 24576;
typedef const __attribute__((address_space(4))) unsigned long long* KArgPtr;
struct Ctx { KArgPtr kp; LAS unsigned char* lds; int G, blk, tid, wid, lane; };
DI Params load_params(KArgPtr k) {
    Params p;
    p.x = (const float*)k[0]; p.meta = (const float*)k[1]; p.rg_w_in = (const float*)k[2]; p.rg_b_in = (const float*)k[3]; p.rg_conv_w = (const float*)k[4]; p.rg_conv_b = (const float*)k[5];
    p.rg_w_gates = (const float*)k[6]; p.rg_b_gates = (const float*)k[7]; p.rg_a_param = (const float*)k[8]; p.rg_w_out = (const float*)k[9]; p.attn_w_qkv = (const float*)k[10]; p.attn_sinks = (const float*)k[11];
    p.attn_w_o = (const float*)k[12]; p.rel_table = (const float*)k[13]; p.ln_gain = (const float*)k[14]; p.ln_bias = (const float*)k[15]; p.router_w = (const float*)k[16]; p.router_bias = (const float*)k[17];
    p.ex_w_gu = (const float*)k[18]; p.ex_w_down = (const float*)k[19]; p.sh_w_gu = (const float*)k[20]; p.sh_w_down = (const float*)k[21]; p.out = (float*)k[22]; p.ws = (char*)k[23];
    return p;
}

DI void tr_tile(const float* src, int N, int k0, int n0, float scale, bf16_t* dst_row0  , int K, bf16_t* dst_lo, LAS bf16_t* T, int lane) {
#pragma unroll 4
    for (int it = 0; it < 8; ++it) {
        const int kk = it * 8 + 2 * (lane >> 4), c4 = (lane & 15) * 4;
        const f32x4 v0 = *(const f32x4*)(src + (size_t)(k0 + kk) * N + n0 + c4) * scale, v1 = *(const f32x4*)(src + (size_t)(k0 + kk + 1) * N + n0 + c4) * scale;
#pragma unroll
        for (int j = 0; j < 4; ++j) *(LAS unsigned*)(T + (c4 + j) * 72 + kk) = pk_bf16(v0[j], v1[j]);
    }
    __builtin_amdgcn_s_waitcnt(0xc07f);
#pragma unroll 4
    for (int it = 0; it < 8; ++it) {
        const int n = it * 8 + (lane >> 3), kc = (lane & 7) * 8;
        const u32x4 w = *(const LAS u32x4*)(T + n * 72 + kc);
        *(u32x4*)(dst_row0 + (size_t)n * K + kc) = w;
    }
    if (dst_lo) {
        __builtin_amdgcn_s_waitcnt(0xc07f);
#pragma unroll 4
        for (int it = 0; it < 8; ++it) {
            const int kk = it * 8 + 2 * (lane >> 4), c4 = (lane & 15) * 4;
            const f32x4 v0 = *(const f32x4*)(src + (size_t)(k0 + kk) * N + n0 + c4) * scale, v1 = *(const f32x4*)(src + (size_t)(k0 + kk + 1) * N + n0 + c4) * scale;
#pragma unroll
            for (int j = 0; j < 4; ++j) { const unsigned hi = pk_bf16(v0[j], v1[j]); *(LAS unsigned*)(T + (c4 + j) * 72 + kk) = pk_bf16(v0[j] - bflo(hi), v1[j] - bfhi(hi)); }
        }
        __builtin_amdgcn_s_waitcnt(0xc07f);
#pragma unroll 4
        for (int it = 0; it < 8; ++it) {
            const int n = it * 8 + (lane >> 3), kc = (lane & 7) * 8;
            const u32x4 w = *(const LAS u32x4*)(T + n * 72 + kc);
            *(u32x4*)(dst_lo + (size_t)n * K + kc) = w;
        }
    }
    __builtin_amdgcn_s_waitcnt(0xc07f);
}
struct Job { const float* src; bf16_t* dst; int count, K, N, mode; };
DI int pair_perm512(int n) { return ((n & 255) >> 7) * 256 + (n >> 8) * 128 + (n & 127); }

DI void phase_prologue(const Ctx& c) {
    const Params p = load_params(c.kp); char* ws = p.ws;
    LAS bf16_t* T = (LAS bf16_t*)(c.lds) + c.wid * (64 * 72);
    const int gw = c.blk * 8 + c.wid, nw = c.G * 8;
#pragma unroll 1
    for (int j = 0; j < 10; ++j) {
        Job jb;
        switch (j) {
            case 0: jb = Job{p.rg_w_in, (bf16_t*)(ws + WS_WIN), 2, 1024, 2048, 0}; break;
            case 1: jb = Job{p.rg_w_gates, (bf16_t*)(ws + WS_WG), 8, 256, 512, 1}; break;
            case 2: jb = Job{p.rg_w_out, (bf16_t*)(ws + WS_WOUT), 2, 1024, 1024, 0}; break;
            case 3: jb = Job{p.attn_w_qkv, (bf16_t*)(ws + WS_WQKV), 2, 1024, 1536, 2}; break;
            case 4: jb = Job{p.attn_w_o, (bf16_t*)(ws + WS_WO), 2, 1024, 1024, 0}; break;
            case 5: jb = Job{p.ex_w_gu, (bf16_t*)(ws + WS_WEGU), 256, 1024, 512, 1}; break;
            case 6: jb = Job{p.ex_w_down, (bf16_t*)(ws + WS_WED), 256, 256, 1024, 0}; break;
            case 7: jb = Job{p.sh_w_gu, (bf16_t*)(ws + WS_WSGU), 4, 1024, 512, 1}; break;
            case 8: jb = Job{p.sh_w_down, (bf16_t*)(ws + WS_WSD), 4, 256, 1024, 0}; break;
            default: jb = Job{p.router_w, (bf16_t*)(ws + WS_WRH), 4, 1024, 64, 3}; break;
        }
        const int tk = jb.K / 64, tn = jb.N / 64, per = tk * tn, total = jb.count * per;
        for (int t = gw; t < total; t += nw) {
            const int mi = t / per, r = t % per, kt = r / tn, ntl = r % tn;
            const float* src = jb.src + (size_t)mi * jb.K * jb.N;
            const int n0 = ntl * 64; int drow = n0; float scale = 1.0f;
            if (jb.mode == 1) drow = pair_perm512(n0);
            if (jb.mode == 2 && n0 < 1024) scale = 0.125f;
            bf16_t* dst = jb.dst + (size_t)mi * jb.K * jb.N + (size_t)drow * jb.K + kt * 64;
            bf16_t* dlo = (jb.mode == 3) ? (bf16_t*)(ws + WS_WRL) + (size_t)mi * jb.K * jb.N + (size_t)drow * jb.K + kt * 64 : nullptr;
            tr_tile(src, jb.N, kt * 64, n0, scale, dst, jb.K, dlo, T, c.lane);
        }
    }
    const size_t gt = (size_t)c.blk * 512 + c.tid, gn = (size_t)c.G * 512;
    bf16_t* HB = (bf16_t*)(ws + WS_HB); bf16_t* HLO = (bf16_t*)(ws + WS_H);
    for (size_t i = gt; i < (size_t)MR * 128; i += gn) {
        const f32x4 a = *(const f32x4*)(p.x + i * 8), b = *(const f32x4*)(p.x + i * 8 + 4);
        u32x4 w; w.x = pk_bf16(a[0], a[1]); w.y = pk_bf16(a[2], a[3]); w.z = pk_bf16(b[0], b[1]); w.w = pk_bf16(b[2], b[3]);
        *(u32x4*)(HB + i * 8) = w;
    }
    for (size_t i = gt; i < (size_t)(MPAD - MR) * 128; i += gn) {
        const int row = MR + (int)(i / 128), c8 = (int)(i % 128) * 8;
        u32x4 w = {0u, 0u, 0u, 0u};
        if (row < NR) { const int m = (row - MR) & 15; const f32x4 a = *(const f32x4*)(p.meta + m * 1024 + c8), b = *(const f32x4*)(p.meta + m * 1024 + c8 + 4);
            w.x = pk_bf16(a[0], a[1]); w.y = pk_bf16(a[2], a[3]); w.z = pk_bf16(b[0], b[1]); w.w = pk_bf16(b[2], b[3]);
            u32x4 l; l.x = pk_bf16(a[0] - bflo(w.x), a[1] - bfhi(w.x)); l.y = pk_bf16(a[2] - bflo(w.y), a[3] - bfhi(w.y)); l.z = pk_bf16(b[0] - bflo(w.z), b[1] - bfhi(w.z)); l.w = pk_bf16(b[2] - bflo(w.w), b[3] - bfhi(w.w));
            *(u32x4*)(HLO + (size_t)row * 1024 + c8) = l; }
        *(u32x4*)(HB + (size_t)row * 1024 + c8) = w;
    }
    int* iota = (int*)(ws + WS_IOTA);
    for (size_t i = gt; i < (size_t)ROWS_ALL; i += gn) iota[i] = (int)i;
    float* C8 = (float*)(ws + WS_C8);
    for (size_t i = gt; i < 2048; i += gn) { const float L = p.rg_a_param[i]; C8[i] = -8.0f * log1pf(expf(-L)); }
}


DI void phase_win(const Ctx& c, int j  ) {
    const Params p = load_params(c.kp); char* ws = p.ws;
    const bf16_t* HB = (const bf16_t*)(ws + WS_HB); const bf16_t* W = (const bf16_t*)(ws + WS_WIN) + (size_t)j * 2048 * 1024;
    bf16_t* YB = (bf16_t*)(ws + WS_U + U_YB); bf16_t* XR = (bf16_t*)(ws + WS_U + U_XR); const float* bias = p.rg_b_in + j * 2048;
    const int mt = c.G - 1 - c.blk;
    if (mt < 64) {
        float x2[2]; block_gemm32<128>(c.lds, (const char*)(HB + (size_t)MR * 1024), 2048, (const char*)(W + (size_t)mt * 32 * 1024), 2048, c.wid, c.lane, x2);
        const int r = c.lane & 31, h = c.lane >> 5, col = mt * 32 + r; const float b = bias[col];
#pragma unroll
        for (int ii = 0; ii < 2; ++ii) { const int row = MR + crow(2 * c.wid + ii, h); const float v = x2[ii] + b;
            if (col < 1024) YB[(size_t)row * 1024 + col] = f2bf(gelu_tanh(v)); else XR[(size_t)row * 1024 + col - 1024] = f2bf(v); }
    }
    DenseSched S; S.init(8, c.G, c.blk, (const char*)HB, (const int*)(ws + WS_IOTA), (const char*)W, 1024, false);
    EpiWin E{YB, XR, bias};
    pg8::gemm_phase(c.lds, c.tid, 1024, 2048u, S, E);
}
DI void load_xr8(const bf16_t* XR, int b, int s, int c8, float (&v)[8]) {
    if (s < -NMETA) {
#pragma unroll
        for (int i = 0; i < 8; ++i) v[i] = 0.f; return; }
    const size_t row = s >= 0 ? (size_t)b * SEQ + s : (size_t)MR + b * NMETA + (s + NMETA);
    const u32x4 w = *(const u32x4*)(XR + row * 1024 + c8);
    v[0] = bflo(w.x); v[1] = bfhi(w.x); v[2] = bflo(w.y); v[3] = bfhi(w.y); v[4] = bflo(w.z); v[5] = bfhi(w.z); v[6] = bflo(w.w); v[7] = bfhi(w.w);
}
DI void phase_conv(const Ctx& c, int j) {
    const Params p = load_params(c.kp); char* ws = p.ws;
    const bf16_t* XR = (const bf16_t*)(ws + WS_U + U_XR); bf16_t* XC = (bf16_t*)(ws + WS_U + U_XC);
    const int c8 = (c.tid & 127) * 8, sub = c.tid >> 7;
    float w0[8], w1[8], w2[8], w3[8], cb[8];
#pragma unroll
    for (int i = 0; i < 8; ++i) { w0[i] = p.rg_conv_w[(j * 4 + 0) * 1024 + c8 + i]; w1[i] = p.rg_conv_w[(j * 4 + 1) * 1024 + c8 + i]; w2[i] = p.rg_conv_w[(j * 4 + 2) * 1024 + c8 + i]; w3[i] = p.rg_conv_w[(j * 4 + 3) * 1024 + c8 + i]; cb[i] = p.rg_conv_b[j * 1024 + c8 + i]; }
    for (int tile = c.blk; tile < 513; tile += c.G) {
        int b, s0;
        if (tile < 512) { b = tile >> 8; s0 = (tile & 255) * 64 + sub * 16; }
        else { if (sub >= 2) continue; b = sub; s0 = -NMETA; }
        float x3[8], x2[8], x1[8], x0[8];
        load_xr8(XR, b, s0 - 3, c8, x3); load_xr8(XR, b, s0 - 2, c8, x2); load_xr8(XR, b, s0 - 1, c8, x1);
#pragma unroll 4
        for (int k = 0; k < 16; ++k) {
            const int s = s0 + k;
            load_xr8(XR, b, s, c8, x0);
            float o[8];
#pragma unroll
            for (int i = 0; i < 8; ++i) o[i] = cb[i] + w0[i] * x3[i] + w1[i] * x2[i] + w2[i] * x1[i] + w3[i] * x0[i];
            const size_t row = s >= 0 ? (size_t)b * SEQ + s : (size_t)MR + b * NMETA + (s + NMETA);
            u32x4 w; w.x = pk_bf16(o[0], o[1]); w.y = pk_bf16(o[2], o[3]); w.z = pk_bf16(o[4], o[5]); w.w = pk_bf16(o[6], o[7]);
            *(u32x4*)(XC + row * 1024 + c8) = w;
#pragma unroll
            for (int i = 0; i < 8; ++i) { x3[i] = x2[i]; x2[i] = x1[i]; x1[i] = x0[i]; }
        }
    }
}
struct GatesSched {
    static constexpr bool GATHER = false;
    int c; const char* A; const char* Bt;
    DI bool next(int i, Unit& u) const {
        if (i >= 4) return false;
        const int T = c + 256 * (i >> 1), ph = i & 1, pm = T >> 2, nb = T & 3, cn = nb * 2 + ph;
        u.A = A + (size_t)nb * 512; u.rows = nullptr; u.arow = pm * 256; u.Bt = Bt + (size_t)cn * 256 * 256 * 2; u.orow = pm * 256; u.pn = cn; u.aux = 0;
        return true;
    }
};
DI void conv_block(const Params& p, int j, const bf16_t* XR, bf16_t* XC, int b, int s0, int ch0, int ngroups, int tid) {
    const int c8 = ch0 + (tid & 31) * 8, grp = tid >> 5;
    if (grp >= ngroups) return;
    float w0[8], w1[8], w2[8], w3[8], cb[8];
#pragma unroll
    for (int i = 0; i < 8; ++i) { w0[i] = p.rg_conv_w[(j * 4 + 0) * 1024 + c8 + i]; w1[i] = p.rg_conv_w[(j * 4 + 1) * 1024 + c8 + i]; w2[i] = p.rg_conv_w[(j * 4 + 2) * 1024 + c8 + i]; w3[i] = p.rg_conv_w[(j * 4 + 3) * 1024 + c8 + i]; cb[i] = p.rg_conv_b[j * 1024 + c8 + i]; }
    const int sb = s0 + grp * 16;
    float x3[8], x2[8], x1[8], x0[8];
    load_xr8(XR, b, sb - 3, c8, x3); load_xr8(XR, b, sb - 2, c8, x2); load_xr8(XR, b, sb - 1, c8, x1);
#pragma unroll 4
    for (int k = 0; k < 16; ++k) {
        const int s = sb + k;
        load_xr8(XR, b, s, c8, x0);
        float o[8];
#pragma unroll
        for (int i = 0; i < 8; ++i) o[i] = cb[i] + w0[i] * x3[i] + w1[i] * x2[i] + w2[i] * x1[i] + w3[i] * x0[i];
        const size_t row = s >= 0 ? (size_t)b * SEQ + s : (size_t)MR + b * NMETA + (s + NMETA);
        u32x4 w; w.x = pk_bf16(o[0], o[1]); w.y = pk_bf16(o[2], o[3]); w.z = pk_bf16(o[4], o[5]); w.w = pk_bf16(o[6], o[7]);
        *(u32x4*)(XC + row * 1024 + c8) = w;
#pragma unroll
        for (int i = 0; i < 8; ++i) { x3[i] = x2[i]; x2[i] = x1[i]; x1[i] = x0[i]; }
    }
}
DI void phase_gates(const Ctx& c, int j) {
    const Params p = load_params(c.kp); char* ws = p.ws;
    const bf16_t* XR = (const bf16_t*)(ws + WS_U + U_XR); bf16_t* XCw = (bf16_t*)(ws + WS_U + U_XC);
    const bf16_t* XC = (const bf16_t*)(ws + WS_U + U_XC); const bf16_t* W = (const bf16_t*)(ws + WS_WG) + (size_t)j * 4 * 512 * 256;
    unsigned* AB = (unsigned*)(ws + WS_U + U_AB);
    const float* bg = p.rg_b_gates + j * 2048; const float* c8 = (const float*)(ws + WS_C8) + j * 1024;
    const int mt = c.G - 1 - c.blk;
#pragma unroll 1
    for (int i = 0; i < 2; ++i) { const int T = c.blk + 256 * i, pm = T >> 2, nb = T & 3; conv_block(p, j, XR, XCw, pm >> 6, (pm & 63) * 256, nb * 256, 16, c.tid); }
    if (mt < 32) { const int nb = mt >> 3; conv_block(p, j, XR, XCw, (c.tid >> 5) & 1, -NMETA - 16 * ((c.tid >> 5) & 1), nb * 256, 2, c.tid); }
    asm volatile("s_waitcnt vmcnt(0)" ::: "memory");
    __syncthreads();
    __builtin_amdgcn_fence(__ATOMIC_ACQUIRE, "agent");
    asm volatile("s_waitcnt vmcnt(0)" ::: "memory");
    if (mt < 32) {
        const int nb = mt >> 3, ph = (mt >> 2) & 1, q = mt & 3;
        const char* Ap = (const char*)(XC + (size_t)MR * 1024 + nb * 256);
        const bf16_t* Wt = W + (size_t)(nb * 512 + ph * 256) * 256;
        float gx[2], ga[2];
        block_gemm32<32>(c.lds, Ap, 2048, (const char*)(Wt + (size_t)(q * 32) * 256), 512, c.wid, c.lane, gx);
        block_gemm32<32>(c.lds, Ap, 2048, (const char*)(Wt + (size_t)(128 + q * 32) * 256), 512, c.wid, c.lane, ga);
        const int r = c.lane & 31, h = c.lane >> 5, cl = ph * 128 + q * 32 + r, ch = nb * 256 + cl;
        const float bgx = bg[nb * 512 + cl], bga = bg[nb * 512 + 256 + cl], cc = c8[ch];
#pragma unroll
        for (int ii = 0; ii < 2; ++ii) { const size_t row = (size_t)(MR + crow(2 * c.wid + ii, h)); float a, b; lru_gate(gx[ii] + bgx, ga[ii] + bga, bf2f(XC[row * 1024 + ch]), cc, a, b);
            AB[row * 1024 + ch] = pk_bf16(a, b); }
    }
    GatesSched S; S.c = c.blk; S.A = (const char*)XC; S.Bt = (const char*)W;
    EpiGates E{AB, XC, bg, c8};
    pg8::gemm_phase(c.lds, c.tid, 256, 2048u, S, E);
    __builtin_amdgcn_fence(__ATOMIC_ACQUIRE, "agent");
    {
        const int T = c.blk + 256 * (c.tid >> 8), pm = T >> 2, nb = T & 3, ch = nb * 256 + (c.tid & 255);
        const size_t row0 = (size_t)pm * 256; f32x2* AGG = (f32x2*)(ws + WS_AGG);
        float A = 1.f, Hh = 0.f;
#pragma unroll 1
        for (int t = 0; t < 256; t += 32) {
            unsigned w[32];
#pragma unroll
            for (int k = 0; k < 32; ++k) w[k] = AB[(row0 + t + k) * 1024 + ch];
#pragma unroll
            for (int k = 0; k < 32; ++k) { const float a = __expf(bflo(w[k])); Hh = a * Hh + bfhi(w[k]); A *= a; }
        }
        AGG[(size_t)pm * 1024 + ch] = (f32x2){A, Hh};
    }
}
DI void phase_scan1(const Ctx& c) {
    char* ws = (char*)c.kp[23];
    const unsigned* AB = (const unsigned*)(ws + WS_U + U_AB); f32x2* AGG = (f32x2*)(ws + WS_AGG);
    for (int item = c.blk; item < 256; item += c.G) {
        const int bc = item >> 1, ch = (item & 1) * 512 + c.tid;
        const size_t row0 = (size_t)bc * 256;
        float A = 1.f, Hh = 0.f;
#pragma unroll 1
        for (int t = 0; t < 256; t += 32) {
            unsigned w[32];
#pragma unroll
            for (int k = 0; k < 32; ++k) w[k] = AB[(row0 + t + k) * 1024 + ch];
#pragma unroll
            for (int k = 0; k < 32; ++k) { const float a = __expf(bflo(w[k])); Hh = a * Hh + bfhi(w[k]); A *= a; }
        }
        AGG[(size_t)bc * 1024 + ch] = (f32x2){A, Hh};
    }
}
DI void phase_scan2(const Ctx& c) {
    char* ws = (char*)c.kp[23];
    const unsigned* AB = (const unsigned*)(ws + WS_U + U_AB); const f32x2* AGG = (const f32x2*)(ws + WS_AGG);
    const bf16_t* YB = (const bf16_t*)(ws + WS_U + U_YB); bf16_t* Z = (bf16_t*)(ws + WS_U + U_Z);
    for (int item = c.blk; item < 256; item += c.G) {
        const int bc = item >> 1, b = bc >> 6, chunk = bc & 63, ch = (item & 1) * 512 + c.tid;
        float h = 0.f;
        {
            unsigned w[NMETA]; float y[NMETA];
#pragma unroll
            for (int m = 0; m < NMETA; ++m) { const size_t row = (size_t)MR + b * NMETA + m; w[m] = AB[row * 1024 + ch]; y[m] = bf2f(YB[row * 1024 + ch]); }
#pragma unroll
            for (int m = 0; m < NMETA; ++m) { const size_t row = (size_t)MR + b * NMETA + m; h = __expf(bflo(w[m])) * h + bfhi(w[m]); if (chunk == 0) Z[row * 1024 + ch] = f2bf(y[m] * h); }
        }
#pragma unroll 1
        for (int c0 = 0; c0 < chunk; c0 += 16) {
            f32x2 g[16];
#pragma unroll
            for (int k = 0; k < 16; ++k) g[k] = (c0 + k < chunk) ? AGG[(size_t)(b * 64 + c0 + k) * 1024 + ch] : (f32x2){1.f, 0.f};
#pragma unroll
            for (int k = 0; k < 16; ++k) h = g[k].x * h + g[k].y;
        }
        const size_t row0 = (size_t)bc * 256;
#pragma unroll 1
        for (int t = 0; t < 256; t += 32) {
            unsigned w[32]; unsigned short y[32];
#pragma unroll
            for (int k = 0; k < 32; ++k) { w[k] = AB[(row0 + t + k) * 1024 + ch]; y[k] = YB[(row0 + t + k) * 1024 + ch]; }
#pragma unroll
            for (int k = 0; k < 32; ++k) { h = __expf(bflo(w[k])) * h + bfhi(w[k]); Z[(row0 + t + k) * 1024 + ch] = f2bf(bf2f(y[k]) * h); }
        }
    }
}
DI void phase_outproj(const Ctx& c, const bf16_t* A, const bf16_t* W, bool first_layer) {
    const Params p = load_params(c.kp); char* ws = p.ws;
    bf16_t* V = (bf16_t*)(ws + WS_V); const bf16_t* HB = (const bf16_t*)(ws + WS_HB); const bf16_t* HLO = (const bf16_t*)(ws + WS_H);
    const int mt = c.G - 1 - c.blk;
    if (mt < 32) {
        float x2[2]; block_gemm32<128>(c.lds, (const char*)(A + (size_t)MR * 1024), 2048, (const char*)(W + (size_t)mt * 32 * 1024), 2048, c.wid, c.lane, x2);
        const int r = c.lane & 31, h = c.lane >> 5, col = mt * 32 + r;
#pragma unroll
        for (int ii = 0; ii < 2; ++ii) { const size_t row = (size_t)(MR + crow(2 * c.wid + ii, h)); V[row * 1024 + col] = f2bf(ALPHA * (bf2f(HB[row * 1024 + col]) + bf2f(HLO[row * 1024 + col])) + x2[ii]); }
    }
    DenseSched S; S.init(4, c.G, c.blk, (const char*)A, (const int*)(ws + WS_IOTA), (const char*)W, 1024, false);
    EpiResid E{V, first_layer ? p.x : nullptr, HB, HLO};
    pg8::gemm_phase(c.lds, c.tid, 1024, 2048u, S, E);
}
DI void phase_qkv(const Ctx& c, int j) {
    const Params p = load_params(c.kp); char* ws = p.ws;
    const bf16_t* HB = (const bf16_t*)(ws + WS_HB); const bf16_t* W = (const bf16_t*)(ws + WS_WQKV) + (size_t)j * 1536 * 1024;
    bf16_t* Q = (bf16_t*)(ws + WS_U + U_QB); bf16_t* KV = (bf16_t*)(ws + WS_U + U_KV);
    const int mt = c.G - 1 - c.blk;
    if (mt < 48) {
        float x2[2]; block_gemm32<128>(c.lds, (const char*)(HB + (size_t)MR * 1024), 2048, (const char*)(W + (size_t)mt * 32 * 1024), 2048, c.wid, c.lane, x2);
        const int r = c.lane & 31, h = c.lane >> 5, col = mt * 32 + r;
#pragma unroll
        for (int ii = 0; ii < 2; ++ii) { const size_t row = (size_t)(MR + crow(2 * c.wid + ii, h)); const bf16_t v = f2bf(x2[ii]);
            if (col < 1024) Q[row * 1024 + col] = v; else KV[row * 512 + col - 1024] = v; }
    }
    DenseSched S; S.init(6, c.G, c.blk, (const char*)HB, (const int*)(ws + WS_IOTA), (const char*)W, 1024, false);
    EpiQkv E{Q, KV};
    pg8::gemm_phase(c.lds, c.tid, 1024, 2048u, S, E);
}
constexpr int AT_KP = 72, AT_VP = 296;
constexpr int AT_K_OFF = 0, AT_V_OFF = 288 * AT_KP * 2, AT_B_OFF = AT_V_OFF + 64 * AT_VP * 2;
DI bf16x8 pack_step(const f32x16& x, int s) {
    u32x4 p;
    p.x = pk_bf16(x[8 * s], x[8 * s + 1]); p.y = pk_bf16(x[8 * s + 2], x[8 * s + 3]); p.z = pk_bf16(x[8 * s + 4], x[8 * s + 5]); p.w = pk_bf16(x[8 * s + 6], x[8 * s + 7]);
    return __builtin_bit_cast(bf16x8, p);
}
DI void phase_attn(const Ctx& c, int j) {
    const Params p = load_params(c.kp); char* ws = p.ws;
    const bf16_t* Q = (const bf16_t*)(ws + WS_U + U_QB); const bf16_t* KV = (const bf16_t*)(ws + WS_U + U_KV);
    bf16_t* O = (bf16_t*)(ws + WS_U + U_OB);
    LAS bf16_t* KI = (LAS bf16_t*)(c.lds + AT_K_OFF); LAS bf16_t* VT = (LAS bf16_t*)(c.lds + AT_V_OFF); LAS float* BT = (LAS float*)(c.lds + AT_B_OFF); LAS float* BTX = (LAS float*)(c.lds + AT_B_OFF + 2560);
    const int lane = c.lane, r = lane & 31, h = lane >> 5, g = c.wid >> 1, qh = c.wid & 1;
    for (int item = c.blk; item < 1032; item += c.G) {
        const bool ismeta = item >= 1024;
        int b, n, hk;
        if (!ismeta) { hk = item & 3; n = (item >> 2) & 127; b = item >> 9; } else { hk = item & 3; b = (item - 1024) >> 2; n = -1; }
        const int head = hk * 4 + g;
        bf16x8 qf[2][4];
        int qi[2];
#pragma unroll
        for (int cb = 0; cb < 2; ++cb) {
            qi[cb] = qh * 64 + cb * 32 + r;
            size_t qrow;
            if (!ismeta) qrow = (size_t)b * SEQ + n * 128 + qi[cb]; else qrow = (size_t)MR + b * NMETA + (qi[cb] & 15);
#pragma unroll
            for (int ks = 0; ks < 4; ++ks) qf[cb][ks] = *(const bf16x8*)(Q + qrow * 1024 + head * 64 + ks * 16 + h * 8);
        }
        __syncthreads();
        {
            u32x4 kvv[5], vvv[5];
#pragma unroll
            for (int it = 0; it < 5; ++it) {
                const int ch = c.tid + 512 * it, kk = ch >> 3, d8 = (ch & 7) * 8;
                long row = -1;
                if (ch < 288 * 8) {
                    if (kk < 16) row = (long)MR + b * NMETA + kk;
                    else if (kk >= 32 && !ismeta) { const int t = n * 128 - 128 + (kk - 32); if (t >= 0) row = (long)b * SEQ + t; }
                }
                kvv[it] = (u32x4){0u, 0u, 0u, 0u}; vvv[it] = (u32x4){0u, 0u, 0u, 0u};
                if (row >= 0) { kvv[it] = *(const u32x4*)(KV + (size_t)row * 512 + hk * 64 + d8); vvv[it] = *(const u32x4*)(KV + (size_t)row * 512 + 256 + hk * 64 + d8); }
            }
#pragma unroll
            for (int it = 0; it < 5; ++it) {
                const int ch = c.tid + 512 * it, kk = ch >> 3, d8 = (ch & 7) * 8;
                if (ch < 288 * 8) {
                    *(LAS u32x4*)(KI + kk * AT_KP + d8) = kvv[it];
                    const int kin = kk & 15, pos = (kk & ~15) | (((kin >> 2) & 1) << 3) | (((kin >> 3) & 1) << 2) | (kin & 3);
                    const unsigned vw[4] = {vvv[it].x, vvv[it].y, vvv[it].z, vvv[it].w};
#pragma unroll
                    for (int i = 0; i < 4; ++i) { VT[(d8 + 2 * i) * AT_VP + pos] = (bf16_t)(vw[i] & 0xffffu); VT[(d8 + 2 * i + 1) * AT_VP + pos] = (bf16_t)(vw[i] >> 16); }
                }
            }
        }
        for (int i = c.tid; i < 4 * 160; i += 512) { const int gg = i / 160, d = i % 160; BT[i] = p.rel_table[kBucket[d] * 16 + hk * 4 + gg]; }
        for (int i = c.tid; i < 4 * 448; i += 512) { const int gg = i / 448, d = i % 448 - 160; BTX[i] = (d >= 0 && d < 128) ? p.rel_table[kBucket[d] * 16 + hk * 4 + gg] : -1e30f; }
        __syncthreads();
        f32x16 o[2][2];
#pragma unroll
        for (int db = 0; db < 2; ++db)
#pragma unroll
            for (int cb = 0; cb < 2; ++cb)
#pragma unroll
                for (int i = 0; i < 16; ++i) o[db][cb][i] = 0.f;
        float mrun[2] = {-1e30f, -1e30f}, lrun[2] = {0.f, 0.f};
        int kt_lo, kt_hi;
        if (ismeta) { kt_lo = 1; kt_hi = 0; }
        else if (qh == 0) { kt_lo = (n == 0) ? 5 : 1; kt_hi = 6; }
        else { kt_lo = (n == 0) ? 5 : 3; kt_hi = 8; }
        const bool active = !(ismeta && qh == 1);
        if (active) {
            for (int it = 0; it <= kt_hi - kt_lo + 1; ++it) {
                const int kt = (it == 0) ? 0 : kt_lo + it - 1;
                f32x16 s[2];
#pragma unroll
                for (int cb = 0; cb < 2; ++cb)
#pragma unroll
                    for (int i = 0; i < 16; ++i) s[cb][i] = 0.f;
#pragma unroll
                for (int ks = 0; ks < 4; ++ks) {
                    const bf16x8 kf = *(const LAS bf16x8*)(KI + (kt * 32 + r) * AT_KP + ks * 16 + h * 8);
#pragma unroll
                    for (int cb = 0; cb < 2; ++cb) s[cb] = __builtin_amdgcn_mfma_f32_32x32x16_bf16(kf, qf[cb][ks], s[cb], 0, 0, 0);
                }
                bf16x8 pf[2][2];
#pragma unroll
                for (int cb = 0; cb < 2; ++cb) {
                    float tmax = -1e30f;
                    if (kt == 0) {
#pragma unroll
                        for (int i = 0; i < 16; ++i) {
                            const int kr = crow(i, h);
                            bool valid; int d;
                            if (ismeta) { d = (qi[cb] & 15) - kr; valid = (kr < 16) && d >= 0; } else { d = NMETA + n * 128 + qi[cb] - kr; valid = kr < 16; }
                            d = d < 0 ? 0 : (d > 159 ? 159 : d);
                            const float sv = valid ? s[cb][i] + BT[g * 160 + d] : -1e30f;
                            s[cb][i] = sv; tmax = fmaxf(tmax, sv);
                        }
                    } else {
                        LAS const float* bx = BTX + g * 448 + (288 + qi[cb] - 32 * (kt - 1) - 4 * h - 27);
#pragma unroll
                        for (int i = 0; i < 16; ++i) { const float sv = s[cb][i] + bx[27 - ((i & 3) + 8 * (i >> 2))]; s[cb][i] = sv; tmax = fmaxf(tmax, sv); }
                    }
                    tmax = fmaxf(tmax, xor32(tmax));
                    const float mnew = fmaxf(mrun[cb], tmax), alpha = __expf(mrun[cb] - mnew);
                    float psum = 0.f;
#pragma unroll
                    for (int i = 0; i < 16; ++i) { const float pv = __expf(s[cb][i] - mnew); s[cb][i] = pv; psum += pv; }
                    lrun[cb] = lrun[cb] * alpha + psum; mrun[cb] = mnew;
#pragma unroll
                    for (int db = 0; db < 2; ++db)
#pragma unroll
                        for (int i = 0; i < 16; ++i) o[db][cb][i] *= alpha;
                    pf[cb][0] = pack_step(s[cb], 0); pf[cb][1] = pack_step(s[cb], 1);
                }
#pragma unroll
                for (int ss = 0; ss < 2; ++ss)
#pragma unroll
                    for (int db = 0; db < 2; ++db) {
                        const bf16x8 vf = *(const LAS bf16x8*)(VT + (db * 32 + r) * AT_VP + kt * 32 + ss * 16 + h * 8);
#pragma unroll
                        for (int cb = 0; cb < 2; ++cb) o[db][cb] = __builtin_amdgcn_mfma_f32_32x32x16_bf16(vf, pf[cb][ss], o[db][cb], 0, 0, 0);
                    }
            }
            const float sink = p.attn_sinks[j * 16 + head];
#pragma unroll
            for (int cb = 0; cb < 2; ++cb) {
                const float ltot = lrun[cb] + xor32(lrun[cb]);
                const float mf = fmaxf(mrun[cb], sink), e1 = __expf(mrun[cb] - mf), den = ltot * e1 + __expf(sink - mf), sc = e1 / den;
                const bool st = ismeta ? (cb == 0 && r < 16) : true;
                if (st) {
                    const size_t qrow = ismeta ? (size_t)MR + b * NMETA + r : (size_t)b * SEQ + n * 128 + qi[cb];
#pragma unroll
                    for (int db = 0; db < 2; ++db)
#pragma unroll
                        for (int q4 = 0; q4 < 4; ++q4) {
                            u32x2 w; w.x = pk_bf16(o[db][cb][4 * q4] * sc, o[db][cb][4 * q4 + 1] * sc); w.y = pk_bf16(o[db][cb][4 * q4 + 2] * sc, o[db][cb][4 * q4 + 3] * sc);
                            *(u32x2*)(O + qrow * 1024 + head * 64 + db * 32 + 8 * q4 + 4 * h) = w;
                        }
                }
            }
        }
    }
    __syncthreads();
}
constexpr int LN_AP = 1032;
constexpr int LN_AHI = 0, LN_ALO = 32 * LN_AP * 2;
constexpr int LN_PART = 0;
constexpr int LN_SC = 133120;
constexpr int LN_CH = LN_SC + 32 * 65 * 4;
constexpr int LN_HIST = LN_CH + 32 * 65 * 4;
static_assert(LN_ALO + 32 * LN_AP * 2 <= LN_SC && LN_HIST + 256 <= LDS_BYTES, "LN LDS map");
DI void phase_lnr(const Ctx& c, int layer) {
    const Params p = load_params(c.kp); char* ws = p.ws;
    const bf16_t* V = (const bf16_t*)(ws + WS_V); float* STAT = (float*)(ws + WS_STAT); bf16_t* HB = (bf16_t*)(ws + WS_HB);
    const float* gain = p.ln_gain + (layer * 2 + 0) * 1024; const float* bias = p.ln_bias + (layer * 2 + 0) * 1024;
    const bf16_t* WRH = (const bf16_t*)(ws + WS_WRH) + (size_t)layer * 64 * 1024; const bf16_t* WRL = (const bf16_t*)(ws + WS_WRL) + (size_t)layer * 64 * 1024;
    const float* rbias = p.router_bias + layer * 64;
    int* IDX = (int*)(ws + WS_IDX); float* WT = (float*)(ws + WS_WT); int* HIST = (int*)(ws + WS_HIST);
    LAS bf16_t* AHI = (LAS bf16_t*)(c.lds + LN_AHI); LAS bf16_t* ALO = (LAS bf16_t*)(c.lds + LN_ALO);
    LAS float* PART = (LAS float*)(c.lds + LN_PART); LAS float* SC = (LAS float*)(c.lds + LN_SC); LAS float* CH = (LAS float*)(c.lds + LN_CH); LAS int* hist = (LAS int*)(c.lds + LN_HIST);
    const int lane = c.lane, r = lane & 31, h = lane >> 5;
    if (c.tid < 64) hist[c.tid] = 0;
    const float rb = rbias[lane]; int myhist = 0;
    const int nt = c.wid & 1, kq = c.wid >> 1;
    bf16x8 bhf[16], blf[16];
    {
        const bf16_t* bh = WRH + (size_t)(nt * 32 + r) * 1024 + kq * 256 + h * 8; const bf16_t* bl = WRL + (size_t)(nt * 32 + r) * 1024 + kq * 256 + h * 8;
#pragma unroll
        for (int ks = 0; ks < 16; ++ks) { bhf[ks] = *(const bf16x8*)(bh + ks * 16); blf[ks] = *(const bf16x8*)(bl + ks * 16); }
    }
    const int nreg = (NLN_TILES - c.blk + c.G - 1) / c.G, ntl = nreg + (c.blk < 2 ? 1 : 0);
#pragma unroll 1
    for (int it = 0; it < ntl; ++it) {
        const bool part = it >= nreg; const int rbase = part ? MR + 16 * c.blk : (c.blk + it * c.G) * 32, wst = part ? 2 : 4, nrb = part ? 1 : 2;
        __syncthreads();
#pragma unroll 1
        for (int rb2 = 0; rb2 < nrb; ++rb2) {
        f32x4 v[2][4], gv[4], bv[4];
#pragma unroll
        for (int rr = 0; rr < 2; ++rr)
#pragma unroll
            for (int jj = 0; jj < 4; ++jj) { const u32x2 w = *(const u32x2*)(V + ((size_t)rbase + c.wid * wst + rb2 * 2 + rr) * 1024 + jj * 256 + lane * 4); v[rr][jj] = (f32x4){bflo(w.x), bfhi(w.x), bflo(w.y), bfhi(w.y)}; }
#pragma unroll
        for (int jj = 0; jj < 4; ++jj) { gv[jj] = *(const f32x4*)(gain + jj * 256 + lane * 4); bv[jj] = *(const f32x4*)(bias + jj * 256 + lane * 4); }
#pragma unroll
        for (int rr = 0; rr < 2; ++rr) {
            const int lrow = c.wid * 4 + rb2 * 2 + rr; const size_t row = (size_t)rbase + c.wid * wst + rb2 * 2 + rr;
            float s = 0.f;
#pragma unroll
            for (int jj = 0; jj < 4; ++jj) s += v[rr][jj][0] + v[rr][jj][1] + v[rr][jj][2] + v[rr][jj][3];
            const float mu = wave_sum(s) * (1.0f / 1024.0f);
            float q = 0.f;
#pragma unroll
            for (int jj = 0; jj < 4; ++jj) { v[rr][jj] = v[rr][jj] - mu; q += v[rr][jj][0] * v[rr][jj][0] + v[rr][jj][1] * v[rr][jj][1] + v[rr][jj][2] * v[rr][jj][2] + v[rr][jj][3] * v[rr][jj][3]; }
            const float rstd = 1.0f / __builtin_sqrtf(wave_sum(q) * (1.0f / 1024.0f) + LN_EPS);
            if (lane == 0) *(f32x2*)(STAT + row * 2) = (f32x2){mu, rstd};
#pragma unroll
            for (int jj = 0; jj < 4; ++jj) {
                const f32x4 y = v[rr][jj] * rstd * gv[jj] + bv[jj];
                const int col = jj * 256 + lane * 4;
                u32x2 hi; hi.x = pk_bf16(y[0], y[1]); hi.y = pk_bf16(y[2], y[3]);
                *(u32x2*)(HB + row * 1024 + col) = hi;
                u32x2 lo; lo.x = pk_bf16(y[0] - bflo(hi.x), y[1] - bfhi(hi.x)); lo.y = pk_bf16(y[2] - bflo(hi.y), y[3] - bfhi(hi.y));
                *(LAS u32x2*)(AHI + lrow * LN_AP + col) = hi; *(LAS u32x2*)(ALO + lrow * LN_AP + col) = lo;
            }
        }
        }
        __syncthreads();
        {
            f32x16 acc;
#pragma unroll
            for (int i = 0; i < 16; ++i) acc[i] = 0.f;
            LAS const bf16_t* ah = AHI + r * LN_AP + kq * 256 + h * 8; LAS const bf16_t* al = ALO + r * LN_AP + kq * 256 + h * 8;
#pragma unroll
            for (int ks = 0; ks < 16; ++ks) {
                const bf16x8 a1 = *(const LAS bf16x8*)(ah + ks * 16), a2 = *(const LAS bf16x8*)(al + ks * 16);
                acc = __builtin_amdgcn_mfma_f32_32x32x16_bf16(a1, bhf[ks], acc, 0, 0, 0);
                acc = __builtin_amdgcn_mfma_f32_32x32x16_bf16(a1, blf[ks], acc, 0, 0, 0);
                acc = __builtin_amdgcn_mfma_f32_32x32x16_bf16(a2, bhf[ks], acc, 0, 0, 0);
            }
            __syncthreads();
#pragma unroll
            for (int i = 0; i < 16; ++i) PART[(kq * 32 + crow(i, h)) * 65 + nt * 32 + r] = acc[i];
        }
        __syncthreads();
#pragma unroll 1
        for (int rr = 0; rr < 2 * nrb; ++rr) {
            const int t = c.wid * 4 + rr; const size_t grow = (size_t)rbase + c.wid * wst + rr;
            const float lg = PART[(0 * 32 + t) * 65 + lane] + PART[(1 * 32 + t) * 65 + lane] + PART[(2 * 32 + t) * 65 + lane] + PART[(3 * 32 + t) * 65 + lane];
            const float sc = sigmoidf_(lg), ch = sc + rb;
            float v = ch; int vi = lane;
#define LN_STEP(F) { const float ov = __builtin_bit_cast(float, F(__builtin_bit_cast(int, v))); const int oi = F(vi); if (ov > v || (ov == v && oi < vi)) { v = ov; vi = oi; } }
            LN_STEP(dpp_x1) LN_STEP(dpp_x2) LN_STEP(dpp_hm)
#undef LN_STEP
            float v2 = (lane == vi) ? -INFINITY : ch;
            v2 = fmaxf(v2, __builtin_bit_cast(float, dpp_x1(__builtin_bit_cast(int, v2)))); v2 = fmaxf(v2, __builtin_bit_cast(float, dpp_x2(__builtin_bit_cast(int, v2)))); v2 = fmaxf(v2, __builtin_bit_cast(float, dpp_hm(__builtin_bit_cast(int, v2))));
            const float gs = v + v2; const int g = lane >> 3;
            int gcnt = 0;
#pragma unroll
            for (int g2 = 0; g2 < 8; ++g2) { const float gv = __builtin_bit_cast(float, __builtin_amdgcn_readlane(__builtin_bit_cast(int, gs), g2 * 8)); gcnt += ((gv > gs) || (gv == gs && g2 < g)) ? 1 : 0; }
            const float cv = (gcnt < 4) ? ch : -INFINITY;
            int rank = 0;
            const int cbits = __builtin_bit_cast(int, cv); const int ckey = (cbits >= 0 ? cbits : (int)(0x80000000u - (unsigned)cbits)) & ~63 | (63 - lane);
            {
                const unsigned long long bal = __ballot(gcnt < 4);
                unsigned gm = 0;
#pragma unroll
                for (int g2 = 0; g2 < 8; ++g2) gm |= (unsigned)((bal >> (8 * g2)) & 1ull) << g2;
#pragma unroll 1
                while (gm) { const int gsel = __builtin_ctz(gm); gm &= gm - 1u;
#pragma unroll
                    for (int jj = 0; jj < 8; ++jj) { const int k = 8 * gsel + jj; const int kk2 = __builtin_amdgcn_readlane(ckey, k); rank += (kk2 > ckey) ? 1 : 0; } }
            }
            const bool chosen = (gcnt < 4) && (rank < 8);
            const float wsum = wave_sum(chosen ? sc : 0.f);
            if (chosen) { IDX[grow * 8 + rank] = lane; WT[grow * 8 + rank] = sc * (2.5f * __builtin_amdgcn_rcpf(wsum + 1e-20f)); myhist += 1; }
        }
    }
    __syncthreads();
    __hip_atomic_fetch_add(&hist[lane], myhist, __ATOMIC_RELAXED, __HIP_MEMORY_SCOPE_WORKGROUP);
    __syncthreads();
    if (c.tid < 64) HIST[c.blk * 64 + c.tid] = hist[c.tid];
}
DI void phase_scatter(const Ctx& c) {
    char* ws = (char*)c.kp[23];
    const int* IDX = (const int*)(ws + WS_IDX); const float* WT = (const float*)(ws + WS_WT); const int* HIST = (const int*)(ws + WS_HIST);
    int* INV = (int*)(ws + WS_INV); int* ROWTOK = (int*)(ws + WS_ROWTOK); float* ROWW = (float*)(ws + WS_ROWW); int* TSTART = (int*)(ws + WS_TSTART);
    LAS int* cnt = (LAS int*)(c.lds); LAS int* pre = cnt + 64; LAS int* pst = pre + 64; LAS int* tst = pst + 80; LAS int* cursor = tst + 80;
    __syncthreads();
    {
        LAS int* ps = cursor + 64;
        const int e = c.tid & 63, part = c.tid >> 6, per = (c.G + 7) >> 3;
        int s0 = 0, m0 = 0;
        for (int b = part * per; b < (part + 1) * per && b < c.G; ++b) { const int v = HIST[b * 64 + e]; s0 += v; if (b < c.blk) m0 += v; }
        ps[part * 64 + e] = s0; ps[512 + part * 64 + e] = m0;
        __syncthreads();
        if (c.tid < 64) { int s1 = 0, m1 = 0;
#pragma unroll
            for (int q = 0; q < 8; ++q) { s1 += ps[q * 64 + c.tid]; m1 += ps[512 + q * 64 + c.tid]; }
            cnt[c.tid] = s1; pre[c.tid] = m1; cursor[c.tid] = 0; }
    }
    __syncthreads();
    if (c.tid == 0) { int ps = 0, ts = 0; for (int e = 0; e < 64; ++e) { pst[e] = ps; tst[e] = ts; const int pad = (cnt[e] + 255) & ~255; ps += pad; ts += pad >> 8; } pst[64] = ps; tst[64] = ts; }
    __syncthreads();
    if (c.blk == 0 && c.tid <= 64) TSTART[c.tid] = tst[c.tid];
    for (int e = c.blk; e < 64; e += c.G) { const int start = pst[e] + cnt[e], end = pst[e + 1]; for (int i = start + c.tid; i < end; i += 512) { ROWTOK[i] = ZROW; ROWW[i] = 0.f; } }
    const int nreg = (NLN_TILES - c.blk + c.G - 1) / c.G, ntl = nreg + (c.blk < 2 ? 1 : 0);
    for (int it = 0; it < ntl; ++it) {
        const bool part = it >= nreg; const size_t a0 = part ? (size_t)(MR + 16 * c.blk) * 8 : (size_t)(c.blk + it * c.G) * 256; const int na = part ? 128 : 256;
        if (c.tid < na) { const size_t a = a0 + c.tid; const int e = IDX[a]; const float w = WT[a];
            const int pos = pst[e] + pre[e] + __hip_atomic_fetch_add(&cursor[e], 1, __ATOMIC_RELAXED, __HIP_MEMORY_SCOPE_WORKGROUP);
            ROWTOK[pos] = (int)(a >> 3); ROWW[pos] = w; INV[a] = pos; }
    }
    __syncthreads();
}
DI int build_tile_table(const Ctx& c, LAS int*& tile_e) {
    const int* TSTART = (const int*)((char*)c.kp[23] + WS_TSTART);
    LAS int* tst = (LAS int*)(c.lds + LDS_MISC); tile_e = tst + 80;
    __syncthreads();
    if (c.tid <= 64) tst[c.tid] = TSTART[c.tid];
    __syncthreads();
    const int nrt = __builtin_amdgcn_readfirstlane(tst[64]);
    for (int t = c.tid; t < nrt; t += 512) { int e = 0;
#pragma unroll
        for (int st = 32; st > 0; st >>= 1) e += (tst[e + st] <= t) ? st : 0;
        tile_e[t] = e; }
    __syncthreads();
    return nrt;
}
DI void phase_egu(const Ctx& c, int layer) {
    char* ws = (char*)c.kp[23];
    LAS int* tile_e; const int nrt = build_tile_table(c, tile_e);
    ExpertSched<false> S; S.c = c.blk; S.nrt = nrt; S.tile_e = tile_e; S.ws = ws;
    S.Wr = ws + WS_WEGU + (size_t)layer * 64 * 512 * 1024 * 2; S.Ws = ws + WS_WSGU + (size_t)layer * 512 * 1024 * 2;
    EpiGu E{(bf16_t*)(ws + WS_ACT), (const float*)(ws + WS_ROWW)};
    pg8::gemm_phase(c.lds, c.tid, 1024, 2048u, S, E);
}
#define GAS __attribute__((address_space(1)))
DI void phase_edown3(const Ctx& c, int layer) {
    char* ws = (char*)c.kp[23];
    LAS int* tile_e; const int nrt = build_tile_table(c, tile_e);
    const int ntiles = nrt + N_SH_TILES;
    const GAS bf16_t* ACT = (const GAS bf16_t*)(ws + WS_ACT); GAS unsigned char* Y8 = (GAS unsigned char*)(ws + WS_U);
    const int lane = c.lane, fr = lane & 15, fq = lane >> 4, wid = c.wid;
    unsigned goff[2];
#pragma unroll
    for (int i = 0; i < 2; ++i) { const int p = c.tid + 512 * i, n = p >> 5, kc = (p & 31) ^ (n & 15); goff[i] = (unsigned)(pg8::perm32(n) * 512 + kc * 16); }
    const unsigned ldsw = (unsigned)wid * 1024u;
    LAS unsigned char* ob = c.lds + 65536 + wid * (32 * 160);
#pragma unroll 1
    for (int k = 0;; ++k) {
        const int tile = k * 256 + (c.blk & 7) * 32 + (c.blk >> 3);
        if (tile >= ntiles) break;
        const char* wd; int orow;
        if (tile < nrt) { const int e = __builtin_amdgcn_readfirstlane(tile_e[tile]); orow = tile * 256; wd = ws + WS_WED + ((size_t)layer * 64 + e) * ((size_t)1024 * 256 * 2); }
        else { orow = SH_BASE + (tile - nrt) * 256; wd = ws + WS_WSD + (size_t)layer * 1024 * 256 * 2; }
#define D2_STAGE(slot, J) do { _Pragma("unroll") for (int _h = 0; _h < 2; ++_h) _Pragma("unroll") for (int _i = 0; _i < 2; ++_i) \
        __builtin_amdgcn_global_load_lds((const unsigned*)(wd + (size_t)(2 * (J) + _h) * (32 * 512) + goff[_i]), (LAS unsigned*)(c.lds + (slot) * 32768 + _h * 16384 + ldsw + _i * 8192), 16, 0, 0); } while (0)
        bf16x8 afr[2][8];
#pragma unroll
        for (int mb = 0; mb < 2; ++mb)
#pragma unroll
            for (int ks = 0; ks < 8; ++ks) afr[mb][ks] = *(const GAS bf16x8*)(ACT + (size_t)(orow + 32 * wid + 16 * mb + fr) * 256 + ks * 32 + fq * 8);
        D2_STAGE(0, 0);
        bf16x8 bfr[8][2];
        f32x4 acc[2][2];
#pragma unroll
        for (int mb = 0; mb < 2; ++mb)
#pragma unroll
            for (int nb = 0; nb < 2; ++nb) acc[mb][nb] = (f32x4){0.f, 0.f, 0.f, 0.f};
#define D2_READ(SLOT, H) do { \
        LAS const unsigned char* sb = c.lds + (SLOT) * 32768 + (H) * 16384; \
        _Pragma("unroll") for (int ks = 0; ks < 8; ++ks) _Pragma("unroll") for (int nb = 0; nb < 2; ++nb) bfr[ks][nb] = *(const LAS bf16x8*)(sb + ((16 * nb + fr) * 32 + ((4 * ks + fq) ^ fr)) * 16); } while (0)
#define D2_MMA() do { \
        asm volatile("s_waitcnt lgkmcnt(0)" ::: "memory"); __builtin_amdgcn_sched_barrier(0); __builtin_amdgcn_s_setprio(1); \
        _Pragma("unroll") for (int ks = 0; ks < 8; ++ks) _Pragma("unroll") for (int mb = 0; mb < 2; ++mb) _Pragma("unroll") for (int nb = 0; nb < 2; ++nb) \
            acc[mb][nb] = __builtin_amdgcn_mfma_f32_16x16x32_bf16(bfr[ks][nb], afr[mb][ks], acc[mb][nb], 0, 0, 0); \
        __builtin_amdgcn_s_setprio(0); __builtin_amdgcn_sched_barrier(0); } while (0)
#define D2_EPI(H, PAR) do { \
        _Pragma("unroll") for (int mb = 0; mb < 2; ++mb) { \
              \
            const float am = fmaxf(fmaxf(fmaxf(__builtin_fabsf(acc[mb][0][0]), __builtin_fabsf(acc[mb][0][1])), fmaxf(__builtin_fabsf(acc[mb][0][2]), __builtin_fabsf(acc[mb][0][3]))), \
                                   fmaxf(fmaxf(__builtin_fabsf(acc[mb][1][0]), __builtin_fabsf(acc[mb][1][1])), fmaxf(__builtin_fabsf(acc[mb][1][2]), __builtin_fabsf(acc[mb][1][3])))); \
            const unsigned eb = ((__float_as_uint(am * (1.0f / 127.0f)) >> 23) & 0xffu) + 1u;        \
            const float inv = __uint_as_float((254u - eb) << 23); \
            unsigned q0 = 0, q1 = 0; \
            q0 = __builtin_amdgcn_cvt_pk_u8_f32(__builtin_fmaf(acc[mb][0][0], inv, 128.0f), 0, q0); q0 = __builtin_amdgcn_cvt_pk_u8_f32(__builtin_fmaf(acc[mb][0][1], inv, 128.0f), 1, q0); \
            q0 = __builtin_amdgcn_cvt_pk_u8_f32(__builtin_fmaf(acc[mb][0][2], inv, 128.0f), 2, q0); q0 = __builtin_amdgcn_cvt_pk_u8_f32(__builtin_fmaf(acc[mb][0][3], inv, 128.0f), 3, q0); \
            q1 = __builtin_amdgcn_cvt_pk_u8_f32(__builtin_fmaf(acc[mb][1][0], inv, 128.0f), 0, q1); q1 = __builtin_amdgcn_cvt_pk_u8_f32(__builtin_fmaf(acc[mb][1][1], inv, 128.0f), 1, q1); \
            q1 = __builtin_amdgcn_cvt_pk_u8_f32(__builtin_fmaf(acc[mb][1][2], inv, 128.0f), 2, q1); q1 = __builtin_amdgcn_cvt_pk_u8_f32(__builtin_fmaf(acc[mb][1][3], inv, 128.0f), 3, q1); \
            *(LAS u32x2*)(ob + (16 * mb + fr) * 160 + PAR * 64 + (H) * 32 + 8 * fq) = (u32x2){q0, q1}; \
            *(LAS unsigned char*)(ob + (16 * mb + fr) * 160 + 128 + (PAR * 2 + (H)) * 4 + fq) = (unsigned char)eb; \
            acc[mb][0] = (f32x4){0.f, 0.f, 0.f, 0.f}; acc[mb][1] = (f32x4){0.f, 0.f, 0.f, 0.f}; \
        } } while (0)
#define D2_EPI2(H, PAR) do { \
        _Pragma("unroll") for (int mb = 0; mb < 2; ++mb) { \
              \
            const float am = fmaxf(fmaxf(fmaxf(__builtin_fabsf(acc2[mb][0][0]), __builtin_fabsf(acc2[mb][0][1])), fmaxf(__builtin_fabsf(acc2[mb][0][2]), __builtin_fabsf(acc2[mb][0][3]))), \
                                   fmaxf(fmaxf(__builtin_fabsf(acc2[mb][1][0]), __builtin_fabsf(acc2[mb][1][1])), fmaxf(__builtin_fabsf(acc2[mb][1][2]), __builtin_fabsf(acc2[mb][1][3])))); \
            const unsigned eb = ((__float_as_uint(am * (1.0f / 127.0f)) >> 23) & 0xffu) + 1u;        \
            const float inv = __uint_as_float((254u - eb) << 23); \
            unsigned q0 = 0, q1 = 0; \
            q0 = __builtin_amdgcn_cvt_pk_u8_f32(__builtin_fmaf(acc2[mb][0][0], inv, 128.0f), 0, q0); q0 = __builtin_amdgcn_cvt_pk_u8_f32(__builtin_fmaf(acc2[mb][0][1], inv, 128.0f), 1, q0); \
            q0 = __builtin_amdgcn_cvt_pk_u8_f32(__builtin_fmaf(acc2[mb][0][2], inv, 128.0f), 2, q0); q0 = __builtin_amdgcn_cvt_pk_u8_f32(__builtin_fmaf(acc2[mb][0][3], inv, 128.0f), 3, q0); \
            q1 = __builtin_amdgcn_cvt_pk_u8_f32(__builtin_fmaf(acc2[mb][1][0], inv, 128.0f), 0, q1); q1 = __builtin_amdgcn_cvt_pk_u8_f32(__builtin_fmaf(acc2[mb][1][1], inv, 128.0f), 1, q1); \
            q1 = __builtin_amdgcn_cvt_pk_u8_f32(__builtin_fmaf(acc2[mb][1][2], inv, 128.0f), 2, q1); q1 = __builtin_amdgcn_cvt_pk_u8_f32(__builtin_fmaf(acc2[mb][1][3], inv, 128.0f), 3, q1); \
            *(LAS u32x2*)(ob + (16 * mb + fr) * 160 + PAR * 64 + (H) * 32 + 8 * fq) = (u32x2){q0, q1}; \
            *(LAS unsigned char*)(ob + (16 * mb + fr) * 160 + 128 + (PAR * 2 + (H)) * 4 + fq) = (unsigned char)eb; \
        } } while (0)
#define D2_BODY(SLOT, J, NW) do { \
        asm volatile("s_waitcnt vmcnt(%0)" :: "n"(NW) : "memory"); \
        __builtin_amdgcn_s_barrier(); \
        if ((J) + 1 < 16) D2_STAGE(1 - (SLOT), (J) + 1); \
        D2_READ(SLOT, 0); D2_MMA(); \
        f32x4 acc2[2][2]; _Pragma("unroll") for (int mb = 0; mb < 2; ++mb) _Pragma("unroll") for (int nb = 0; nb < 2; ++nb) { acc2[mb][nb] = acc[mb][nb]; acc[mb][nb] = (f32x4){0.f, 0.f, 0.f, 0.f}; } \
        D2_READ(SLOT, 1);        \
        D2_EPI2(0, (SLOT)); \
        D2_MMA(); \
        D2_EPI(1, (SLOT)); \
        if ((SLOT) == 1) {      \
            _Pragma("unroll") for (int i = 0; i < 4; ++i) { const int q = lane + 64 * i, rr = q >> 3, c16 = q & 7; \
                const u32x4 w = *(const LAS u32x4*)(ob + rr * 160 + c16 * 16); \
                *(GAS u32x4*)(Y8 + (size_t)(orow + 32 * wid + rr) * Y8P + ((J) >> 1) * 128 + c16 * 16) = w; } \
            if (lane < 32) { const u32x4 w = *(const LAS u32x4*)(ob + lane * 160 + 128); \
                *(GAS u32x4*)(Y8 + (size_t)(orow + 32 * wid + lane) * Y8P + 1024 + ((J) >> 1) * 16) = w; } \
        } } while (0)
        D2_BODY(0, 0, 0); D2_BODY(1, 1, 0);
#pragma unroll 1
        for (int J = 2; J < 16; J += 2) { D2_BODY(0, J, 5); D2_BODY(1, J + 1, 0); }
        asm volatile("s_waitcnt vmcnt(0)" ::: "memory");
        __syncthreads();
#undef D2_BODY
#undef D2_READ
#undef D2_MMA
#undef D2_EPI
#undef D2_EPI2
#undef D2_STAGE
    }
}
DI void phase_cln(const Ctx& c, int layer) {
    const Params p = load_params(c.kp); char* ws = p.ws;
    bf16_t* HLO = (bf16_t*)(ws + WS_H); bf16_t* HB = (bf16_t*)(ws + WS_HB); const unsigned char* Y8 = (const unsigned char*)(ws + WS_U); const int* INV = (const int*)(ws + WS_INV);
    const float* gain = p.ln_gain + (layer * 2 + 1) * 1024; const float* bias = p.ln_bias + (layer * 2 + 1) * 1024;
    const bf16_t* V = (const bf16_t*)(ws + WS_V); const float* STAT = (const float*)(ws + WS_STAT);
    const float* gain1 = p.ln_gain + (layer * 2 + 0) * 1024; const float* bias1 = p.ln_bias + (layer * 2 + 0) * 1024;
    const bool last = layer == 3; const int lane = c.lane, c0 = lane * 8;
    f32x4 gv[4], bv[4], g1[4], b1[4];
#pragma unroll
    for (int s = 0; s < 2; ++s)
#pragma unroll
        for (int q = 0; q < 2; ++q) { gv[s * 2 + q] = *(const f32x4*)(gain + s * 512 + c0 + q * 4); bv[s * 2 + q] = *(const f32x4*)(bias + s * 512 + c0 + q * 4);
            g1[s * 2 + q] = *(const f32x4*)(gain1 + s * 512 + c0 + q * 4) * ALPHA; b1[s * 2 + q] = *(const f32x4*)(bias1 + s * 512 + c0 + q * 4) * ALPHA; }
    const int nrows = last ? MR : NR;
    const int stride = c.G * 8;
    int row0 = c.blk * 8 + c.wid;
    int pA = 0, pB = 0;
    { const int rA = row0 < nrows ? row0 : 0, rB = row0 + stride < nrows ? row0 + stride : 0;
      pA = (lane < 8) ? INV[(size_t)rA * 8 + lane] : (SH_BASE + rA); pB = (lane < 8) ? INV[(size_t)rB * 8 + lane] : (SH_BASE + rB); }
    for (; row0 < nrows; row0 += 2 * stride) {
        const int rows2[2] = {row0, row0 + stride};
        const int myp[2] = {pA, pB};
        { const int nA = row0 + 2 * stride, nB = row0 + 3 * stride; const int rA = nA < nrows ? nA : 0, rB = nB < nrows ? nB : 0;
          pA = (lane < 8) ? INV[(size_t)rA * 8 + lane] : (SH_BASE + rA); pB = (lane < 8) ? INV[(size_t)rB * 8 + lane] : (SH_BASE + rB); }
        f32x4 a[2][4];
#pragma unroll
        for (int t = 0; t < 2; ++t) { const int row = rows2[t] < nrows ? rows2[t] : 0;
            const f32x2 st = *(const f32x2*)(STAT + (size_t)row * 2);
#pragma unroll
            for (int s2 = 0; s2 < 2; ++s2) { const u32x4 w = *(const u32x4*)(V + (size_t)row * 1024 + s2 * 512 + c0);
                a[t][s2 * 2] = ((f32x4){bflo(w.x), bfhi(w.x), bflo(w.y), bfhi(w.y)} - st[0]) * st[1] * g1[s2 * 2] + b1[s2 * 2];
                a[t][s2 * 2 + 1] = ((f32x4){bflo(w.z), bfhi(w.z), bflo(w.w), bfhi(w.w)} - st[0]) * st[1] * g1[s2 * 2 + 1] + b1[s2 * 2 + 1]; } }
        u32x2 yw[2][9][2]; float ysc[2][9][2];
#pragma unroll
        for (int t = 0; t < 2; ++t)
#pragma unroll
            for (int k = 0; k < 9; ++k) { const int pos = __builtin_amdgcn_readlane(myp[t], k); const unsigned char* yr = Y8 + (size_t)pos * Y8P;
#pragma unroll
                for (int s2 = 0; s2 < 2; ++s2) { yw[t][k][s2] = *(const u32x2*)(yr + s2 * 512 + c0); ysc[t][k][s2] = __uint_as_float((unsigned)yr[1024 + s2 * 64 + lane] << 23); } }
#pragma unroll
        for (int t = 0; t < 2; ++t) {
#pragma unroll
            for (int k = 0; k < 9; ++k)
#pragma unroll
                for (int s2 = 0; s2 < 2; ++s2) { const u32x2 w = yw[t][k][s2]; const float sc = ysc[t][k][s2], off = -128.0f * sc;
                    a[t][s2 * 2][0] += (float)(w.x & 0xffu) * sc + off; a[t][s2 * 2][1] += (float)((w.x >> 8) & 0xffu) * sc + off; a[t][s2 * 2][2] += (float)((w.x >> 16) & 0xffu) * sc + off; a[t][s2 * 2][3] += (float)(w.x >> 24) * sc + off;
                    a[t][s2 * 2 + 1][0] += (float)(w.y & 0xffu) * sc + off; a[t][s2 * 2 + 1][1] += (float)((w.y >> 8) & 0xffu) * sc + off; a[t][s2 * 2 + 1][2] += (float)((w.y >> 16) & 0xffu) * sc + off; a[t][s2 * 2 + 1][3] += (float)(w.y >> 24) * sc + off; }
            float sm = 0.f;
#pragma unroll
            for (int i = 0; i < 4; ++i) sm += a[t][i][0] + a[t][i][1] + a[t][i][2] + a[t][i][3];
            const float mu = wave_sum(sm) * (1.0f / 1024.0f);
            float q2 = 0.f;
#pragma unroll
            for (int i = 0; i < 4; ++i) { a[t][i] = a[t][i] - mu; q2 += a[t][i][0] * a[t][i][0] + a[t][i][1] * a[t][i][1] + a[t][i][2] * a[t][i][2] + a[t][i][3] * a[t][i][3]; }
            const float rstd = 1.0f / __builtin_sqrtf(wave_sum(q2) * (1.0f / 1024.0f) + LN_EPS);
            if (rows2[t] < nrows) {
#pragma unroll
                for (int s2 = 0; s2 < 2; ++s2) {
                    const f32x4 y0 = a[t][s2 * 2] * rstd * gv[s2 * 2] + bv[s2 * 2], y1 = a[t][s2 * 2 + 1] * rstd * gv[s2 * 2 + 1] + bv[s2 * 2 + 1];
                    const size_t o = (size_t)rows2[t] * 1024 + s2 * 512 + c0;
                    if (last) { *(f32x4*)(p.out + o) = y0; *(f32x4*)(p.out + o + 4) = y1; }
                    else {
                        u32x4 w; w.x = pk_bf16(y0[0], y0[1]); w.y = pk_bf16(y0[2], y0[3]); w.z = pk_bf16(y1[0], y1[1]); w.w = pk_bf16(y1[2], y1[3]);
                        u32x4 l; l.x = pk_bf16(y0[0] - bflo(w.x), y0[1] - bfhi(w.x)); l.y = pk_bf16(y0[2] - bflo(w.y), y0[3] - bfhi(w.y)); l.z = pk_bf16(y1[0] - bflo(w.z), y1[1] - bfhi(w.z)); l.w = pk_bf16(y1[2] - bflo(w.w), y1[3] - bfhi(w.w));
                        *(u32x4*)(HB + o) = w; *(u32x4*)(HLO + o) = l; }
                }
            }
        }
    }
}

DI Ctx make_ctx(unsigned char* smem) {
    Ctx c; c.kp = (KArgPtr)__builtin_amdgcn_kernarg_segment_ptr(); c.lds = (LAS unsigned char*)smem; c.G = (int)gridDim.x; c.blk = (int)blockIdx.x; c.tid = (int)threadIdx.x; c.wid = __builtin_amdgcn_readfirstlane((int)threadIdx.x >> 6); c.lane = (int)threadIdx.x & 63;
    return c;
}
DI void run_phase(const Ctx& c0, int ph, int arg) {
    Ctx c = c0;
    { int t = (int)threadIdx.x; asm volatile("" : "+v"(t)); c.tid = t; c.lane = t & 63; c.wid = __builtin_amdgcn_readfirstlane(t >> 6);
      KArgPtr k = c0.kp; asm volatile("" : "+s"(k)); c.kp = k;
      int b = c0.blk; asm volatile("" : "+s"(b)); c.blk = b; int g = c0.G; asm volatile("" : "+s"(g)); c.G = g; }
    char* ws = (char*)c.kp[23];
    switch (ph) {
        case 0: phase_prologue(c); break;
        case 1: phase_win(c, arg); break;
        case 2: phase_conv(c, arg); break;
        case 3: phase_gates(c, arg); break;
        case 4: phase_scan1(c); break;
        case 5: phase_scan2(c); break;
        case 6: phase_outproj(c, (const bf16_t*)(ws + WS_U + U_Z), (const bf16_t*)(ws + WS_WOUT) + (size_t)arg * 1024 * 1024, arg == 0); break;
        case 7: phase_qkv(c, arg); break;
        case 8: phase_attn(c, arg); break;
        case 9: phase_outproj(c, (const bf16_t*)(ws + WS_U + U_OB), (const bf16_t*)(ws + WS_WO) + (size_t)arg * 1024 * 1024, false); break;
        case 10: phase_lnr(c, arg); break;
        case 11: phase_scatter(c); break;
        case 12: phase_egu(c, arg); break;
        case 13: phase_edown3(c, arg); break;
        default: phase_cln(c, arg); break;
    }
}
DI void grid_sync(const Ctx& c0, XcdBarrier b) { KArgPtr k = c0.kp; asm volatile("" : "+s"(k)); b.bar = (unsigned*)((char*)k[23] + WS_CTL); unsigned x = b.x; asm volatile("" : "+s"(x)); b.x = x; xcd_barrier(b); }
#ifndef PROBE_REP
#define PROBE_REP 0
#endif
#if PROBE_REP
#define RUN(ph, arg) do { int _n = 1 + ((PROBE_REP >> (ph)) & 1); asm volatile("" : "+s"(_n)); _Pragma("unroll 1") for (int _r = 0; _r < _n; ++_r) run_phase(c, ph, arg); grid_sync(c, bar); } while (0)
#else
#define RUN(ph, arg) do { run_phase(c, ph, arg); grid_sync(c, bar); } while (0)
#endif
__global__ void __launch_bounds__(512, 2) fwd_all(Params p) {
    extern __shared__ __attribute__((aligned(16))) unsigned char smem[];
    const Ctx c = make_ctx(smem);
    volatile LAS unsigned* st = (volatile LAS unsigned*)(c.lds + LDS_BYTES - 16);
    if (c.tid == 0) { st[0] = 0u; st[1] = 0u; st[2] = 0u; st[3] = 0u; }
    __syncthreads();
    const XcdBarrier bar = xcd_barrier_post((unsigned*)((char*)c.kp[23] + WS_CTL), st);
    RUN(0, 0);
#pragma unroll 1
    for (int layer = 0; layer < 4; ++layer) {
        const int j = layer >> 1;
        if ((layer & 1) == 0) {
            RUN(1, j); RUN(3, j);
            RUN(5, 0); RUN(6, j);
        } else {
            RUN(7, j); RUN(8, j); RUN(9, j);
        }
        RUN(10, layer); RUN(11, 0); RUN(12, layer);
        RUN(13, layer); RUN(14, layer);
    }
}

#if !MK_ONE_LAUNCH
template <int PH> __global__ void __launch_bounds__(512, 2) k_phase(Params p, int arg) {
    extern __shared__ __attribute__((aligned(16))) unsigned char smem[];
    const Ctx c = make_ctx(smem);
    run_phase(c, PH, arg);
}

template <int PH> static void launch_phase(const Params& p, int arg, int grid, hipStream_t stream) {
    static bool attr = false;
    if (!attr) { if (hipFuncSetAttribute((const void*)k_phase<PH>, hipFuncAttributeMaxDynamicSharedMemorySize, LDS_BYTES) != hipSuccess) fprintf(stderr, "kernel_launch: hipFuncSetAttribute failed (phase %d)\n", PH); attr = true; }
    hipLaunchKernelGGL(k_phase<PH>, dim3(grid), dim3(512), LDS_BYTES, stream, p, arg);
}
#endif

extern "C" void kernel_launch(void* const* d_in, const int* in_sizes, int n_in, void* d_out, int out_size, void* d_ws, size_t ws_size, hipStream_t stream) {
    if (n_in != 22 || ws_size < WS_END || out_size != MR * D) { fprintf(stderr, "kernel_launch: unexpected arguments (n_in %d, out %d, ws %zu, need %zu)\n", n_in, out_size, ws_size, (size_t)WS_END); return; }
    Params p{};
    p.x = (const float*)d_in[0]; p.meta = (const float*)d_in[1]; p.rg_w_in = (const float*)d_in[2]; p.rg_b_in = (const float*)d_in[3]; p.rg_conv_w = (const float*)d_in[4]; p.rg_conv_b = (const float*)d_in[5];
    p.rg_w_gates = (const float*)d_in[6]; p.rg_b_gates = (const float*)d_in[7]; p.rg_a_param = (const float*)d_in[8]; p.rg_w_out = (const float*)d_in[9]; p.attn_w_qkv = (const float*)d_in[10]; p.attn_sinks = (const float*)d_in[11];
    p.attn_w_o = (const float*)d_in[12]; p.rel_table = (const float*)d_in[13]; p.ln_gain = (const float*)d_in[14]; p.ln_bias = (const float*)d_in[15]; p.router_w = (const float*)d_in[16]; p.router_bias = (const float*)d_in[17];
    p.ex_w_gu = (const float*)d_in[18]; p.ex_w_down = (const float*)d_in[19]; p.sh_w_gu = (const float*)d_in[20]; p.sh_w_down = (const float*)d_in[21];
    p.out = (float*)d_out; p.ws = (char*)d_ws;
    const int grid = 256;
    (void)hipMemsetAsync((char*)d_ws + WS_CTL, 0, 65536, stream);
#if MK_ONE_LAUNCH
    static int ok = 0;
    if (!ok) {
        int dev = 0, cus = 0, per_cu = 0;
        if (hipGetDevice(&dev) != hipSuccess || hipDeviceGetAttribute(&cus, hipDeviceAttributeMultiprocessorCount, dev) != hipSuccess) { fprintf(stderr, "kernel_launch: device query failed\n"); return; }
        if (hipFuncSetAttribute((const void*)fwd_all, hipFuncAttributeMaxDynamicSharedMemorySize, LDS_BYTES) != hipSuccess) { fprintf(stderr, "kernel_launch: hipFuncSetAttribute failed\n"); return; }
        if (hipOccupancyMaxActiveBlocksPerMultiprocessor(&per_cu, (const void*)fwd_all, 512, LDS_BYTES) != hipSuccess || per_cu < 1) { fprintf(stderr, "kernel_launch: occupancy query says %d\n", per_cu); return; }
        if (cus * per_cu < grid) { fprintf(stderr, "kernel_launch: %d CUs x %d < %d workgroups: not resident\n", cus, per_cu, grid); return; }
        ok = 1;
    }
    hipLaunchKernelGGL(fwd_all, dim3(grid), dim3(512), LDS_BYTES, stream, p);
#else
    launch_phase<0>(p, 0, grid, stream);
    for (int layer = 0; layer < 4; ++layer) {
        const int j = layer >> 1;
        if ((layer & 1) == 0) {
            launch_phase<1>(p, j, grid, stream); launch_phase<3>(p, j, grid, stream);
            launch_phase<5>(p, 0, grid, stream); launch_phase<6>(p, j, grid, stream);
        } else {
            launch_phase<7>(p, j, grid, stream); launch_phase<8>(p, j, grid, stream); launch_phase<9>(p, j, grid, stream);
        }
        launch_phase<10>(p, layer, grid, stream); launch_phase<11>(p, 0, grid, stream); launch_phase<12>(p, layer, grid, stream); launch_phase<13>(p, layer, grid, stream); launch_phase<14>(p, layer, grid, stream);
    }
#endif
}
```

```cpp
#include <hip/hip_runtime.h>
#include <cstdio>
#include <cstdint>

#ifndef MK_ONE_LAUNCH
#define MK_ONE_LAUNCH 1
#endif

#define DI __device__ __forceinline__
#define LAS __attribute__((address_space(3)))
typedef unsigned short bf16_t;
typedef short bf16x8 __attribute__((ext_vector_type(8)));
typedef float f32x4 __attribute__((ext_vector_type(4)));
typedef float f32x2 __attribute__((ext_vector_type(2)));
typedef float f32x16 __attribute__((ext_vector_type(16)));
typedef unsigned u32x4 __attribute__((ext_vector_type(4)));
typedef unsigned u32x2 __attribute__((ext_vector_type(2)));

constexpr int D = 1024, NBATCH = 2, SEQ = 16384, NMETA = 16;
constexpr int MR = NBATCH * SEQ;
constexpr int NR = MR + NBATCH * NMETA;
constexpr int ZROW = NR;
constexpr int MPAD = 33024;
constexpr int NEXP = 64, TOPK = 8, DE = 256;
constexpr int RT_MAX = 278784;
constexpr int SH_BASE = RT_MAX;
constexpr int ROWS_ALL = RT_MAX + MPAD;
constexpr int N_SH_TILES = MPAD / 256;
constexpr int NLN_TILES = MR / 32;
constexpr float ALPHA = 1.681792830507429f;
constexpr float LN_EPS = 1e-5f;
constexpr int MAXG = 1024;

constexpr size_t al256(size_t x) { return (x + 255) & ~(size_t)255; }
constexpr size_t WS_CTL = 0;
constexpr size_t CTL_FLAGS = 16384;
constexpr size_t WS_IOTA = 65536;
constexpr size_t WS_WIN = al256(WS_IOTA + (size_t)ROWS_ALL * 4);
constexpr size_t WS_WG = WS_WIN + (size_t)2 * 2048 * 1024 * 2;
constexpr size_t WS_WOUT = WS_WG + (size_t)2 * 4 * 512 * 256 * 2;
constexpr size_t WS_WQKV = WS_WOUT + (size_t)2 * 1024 * 1024 * 2;
constexpr size_t WS_WO = WS_WQKV + (size_t)2 * 1536 * 1024 * 2;
constexpr size_t WS_WEGU = WS_WO + (size_t)2 * 1024 * 1024 * 2;
constexpr size_t WS_WED = WS_WEGU + (size_t)4 * 64 * 512 * 1024 * 2;
constexpr size_t WS_WSGU = WS_WED + (size_t)4 * 64 * 1024 * 256 * 2;
constexpr size_t WS_WSD = WS_WSGU + (size_t)4 * 512 * 1024 * 2;
constexpr size_t WS_WRH = WS_WSD + (size_t)4 * 1024 * 256 * 2;
constexpr size_t WS_WRL = WS_WRH + (size_t)4 * 64 * 1024 * 2;
constexpr size_t WS_C8 = WS_WRL + (size_t)4 * 64 * 1024 * 2;
constexpr size_t WS_H = al256(WS_C8 + 2 * 1024 * 4);
constexpr size_t WS_HB = WS_H + (size_t)MPAD * 1024 * 4;
constexpr size_t WS_V = WS_HB + (size_t)MPAD * 1024 * 2;
constexpr size_t WS_U = WS_V + (size_t)MPAD * 1024 * 4;
constexpr int YP = 1088;
constexpr size_t U_BYTES = (size_t)ROWS_ALL * YP * 2;
constexpr int Y8P = 1152;
constexpr size_t ROWB = (size_t)MPAD * 1024 * 2;
constexpr size_t U_YB = 0, U_XR = ROWB, U_XC = 2 * ROWB, U_Z = 3 * ROWB, U_AB = 4 * ROWB;
constexpr size_t U_QB = 0, U_KV = ROWB, U_OB = ROWB + ROWB / 2;
constexpr size_t WS_ACT = WS_U + U_BYTES;
constexpr size_t WS_IDX = WS_ACT + (size_t)ROWS_ALL * 256 * 2;
constexpr size_t WS_WT = al256(WS_IDX + (size_t)NR * 8 * 4);
constexpr size_t WS_INV = al256(WS_WT + (size_t)NR * 8 * 4);
constexpr size_t WS_ROWTOK = al256(WS_INV + (size_t)NR * 8 * 4);
constexpr size_t WS_ROWW = al256(WS_ROWTOK + (size_t)RT_MAX * 4);
constexpr size_t WS_HIST = al256(WS_ROWW + (size_t)RT_MAX * 4);
constexpr size_t WS_TSTART = al256(WS_HIST + (size_t)MAXG * 64 * 4);
constexpr size_t WS_AGG = al256(WS_TSTART + 80 * 4);
constexpr size_t WS_STAT = al256(WS_AGG + (size_t)2 * 64 * 1024 * 8);
constexpr size_t WS_END = al256(WS_STAT + (size_t)MPAD * 8);
static_assert(U_AB + 2 * ROWB <= U_BYTES, "U too small");

struct Params {
    const float* x; const float* meta; const float* rg_w_in; const float* rg_b_in; const float* rg_conv_w; const float* rg_conv_b; const float* rg_w_gates; const float* rg_b_gates;
    const float* rg_a_param; const float* rg_w_out; const float* attn_w_qkv; const float* attn_sinks; const float* attn_w_o; const float* rel_table; const float* ln_gain; const float* ln_bias;
    const float* router_w; const float* router_bias; const float* ex_w_gu; const float* ex_w_down; const float* sh_w_gu; const float* sh_w_down;
    float* out; char* ws;
};

typedef __bf16 bf16x2_t __attribute__((ext_vector_type(2)));
DI unsigned pk_bf16(float lo, float hi) { const f32x2 v = {lo, hi}; return __builtin_bit_cast(unsigned, __builtin_convertvector(v, bf16x2_t)); }
DI bf16_t f2bf(float f) { return (bf16_t)(pk_bf16(f, 0.f) & 0xffffu); }
DI float bf2f(unsigned b) { return __uint_as_float(b << 16); }
DI float bflo(unsigned p) { return __uint_as_float(p << 16); }
DI float bfhi(unsigned p) { return __uint_as_float(p & 0xffff0000u); }
DI void res8(u32x4 hi, u32x4 lo, float (&h)[8]) {
    h[0] = bflo(hi.x) + bflo(lo.x); h[1] = bfhi(hi.x) + bfhi(lo.x); h[2] = bflo(hi.y) + bflo(lo.y); h[3] = bfhi(hi.y) + bfhi(lo.y);
    h[4] = bflo(hi.z) + bflo(lo.z); h[5] = bfhi(hi.z) + bfhi(lo.z); h[6] = bflo(hi.w) + bflo(lo.w); h[7] = bfhi(hi.w) + bfhi(lo.w);
}
DI float sigmoidf_(float x) { return __builtin_amdgcn_rcpf(1.0f + __expf(-x)); }
DI float gelu_tanh(float x) { const float u = 1.5957691216057308f * (x + 0.044715f * x * x * x); return x * sigmoidf_(u); }
DI float silu_mul(float g, float u) { return g * sigmoidf_(g) * u; }
DI void lru_gate(float gx, float ga, float xc, float c8  , float& la, float& bx) {
    const float gate_x = sigmoidf_(gx), gate_a = sigmoidf_(ga);
    la = c8 * gate_a;
    const float a = __expf(la);
    const float x2 = 2.0f * la;
    const float omp = -x2 * (1.0f + x2 * 0.5f * (1.0f + x2 * (1.0f / 3.0f) * (1.0f + x2 * 0.25f * (1.0f + x2 * 0.2f))));
    const float om = (x2 > -0.3f) ? omp : 1.0f - a * a;
    bx = xc * gate_x * __builtin_amdgcn_sqrtf(om);
}
DI int dpp_x1(int v) { return __builtin_amdgcn_mov_dpp(v, 0xB1, 0xF, 0xF, true); }
DI int dpp_x2(int v) { return __builtin_amdgcn_mov_dpp(v, 0x4E, 0xF, 0xF, true); }
DI int dpp_hm(int v) { return __builtin_amdgcn_mov_dpp(v, 0x141, 0xF, 0xF, true); }
DI float xor32(float x, int lane) {
    const auto r = __builtin_amdgcn_permlane32_swap(__builtin_bit_cast(unsigned, x), __builtin_bit_cast(unsigned, x), false, false);
    return __builtin_bit_cast(float, (lane & 32) ? r[0] : r[1]);
}
DI float wave_sum(float v) {
    v += __builtin_bit_cast(float, __builtin_amdgcn_mov_dpp(__builtin_bit_cast(int, v), 0xB1, 0xF, 0xF, true));
    v += __builtin_bit_cast(float, __builtin_amdgcn_mov_dpp(__builtin_bit_cast(int, v), 0x4E, 0xF, 0xF, true));
    v += __builtin_bit_cast(float, __builtin_amdgcn_mov_dpp(__builtin_bit_cast(int, v), 0x141, 0xF, 0xF, true));
    v += __builtin_bit_cast(float, __builtin_amdgcn_mov_dpp(__builtin_bit_cast(int, v), 0x140, 0xF, 0xF, true));
    const int b = __builtin_bit_cast(int, v);
    return (__builtin_bit_cast(float, __builtin_amdgcn_readlane(b, 0)) + __builtin_bit_cast(float, __builtin_amdgcn_readlane(b, 16))) + (__builtin_bit_cast(float, __builtin_amdgcn_readlane(b, 32)) + __builtin_bit_cast(float, __builtin_amdgcn_readlane(b, 48)));
}

__device__ const unsigned char kBucket[160] = {
    0, 1, 2, 3, 4, 5, 6, 7, 8, 9, 10, 11, 12, 13, 14, 15, 16, 16, 16, 17, 17, 18, 18, 18, 19, 19, 19, 20, 20, 20, 20, 21, 21, 21, 21, 22, 22, 22, 22, 22, 23, 23, 23, 23, 23, 23, 24, 24, 24, 24, 24, 24,
    25, 25, 25, 25, 25, 25, 25, 26, 26, 26, 26, 26, 26, 26, 26, 27, 27, 27, 27, 27, 27, 27, 27, 27, 27, 28, 28, 28, 28, 28, 28, 28, 28, 28, 28, 29, 29, 29, 29, 29, 29, 29, 29, 29, 29, 29, 29,
    30, 30, 30, 30, 30, 30, 30, 30, 30, 30, 30, 30, 30, 30, 31, 31, 31, 31, 31, 31, 31, 31, 31, 31, 31, 31, 31, 31, 31, 31, 31, 31, 31, 31, 31, 31, 31, 31, 31, 31, 31, 31, 31, 31, 31, 31, 31,
    31, 31, 31, 31, 31, 31, 31, 31, 31, 31, 31, 31, 31, 31};

#define XB_TMO      128
#define XB_XCNT(j)  (256  + 64 * (j))
#define XB_XSUB(j)  (1280 + 64 * (j))
#define XB_XGEN(j)  (2304 + 64 * (j))
#define XB_TOP      3328
#define XB_TOPGEN   3392
#define XCD_BAR_WORDS 3456
#define XB_SPIN_CAP (1u << 22)
DI unsigned xb_ld(unsigned* p)              { return __hip_atomic_load(p, __ATOMIC_RELAXED, __HIP_MEMORY_SCOPE_AGENT); }
DI unsigned xb_add(unsigned* p, unsigned v) { return __hip_atomic_fetch_add(p, v, __ATOMIC_RELAXED, __HIP_MEMORY_SCOPE_AGENT); }
DI unsigned xb_xcc_id() { return (unsigned)__builtin_amdgcn_s_getreg((3 << 11) | 20) & 0xFu; }
#define XB_SPIN(cond, bar) do { unsigned _sp = 0; while (cond) { __builtin_amdgcn_s_sleep(1); \
    if ((++_sp & 255u) == 0u) { if (xb_ld(&(bar)[XB_TMO])) break; if (_sp > XB_SPIN_CAP) { atomicAdd(&(bar)[XB_TMO], 1u); break; } } } } while (0)
struct XcdBarrier { unsigned* bar; unsigned x; volatile LAS unsigned* st; };
DI XcdBarrier xcd_barrier_post(unsigned* bar, volatile LAS unsigned* st) {
    XcdBarrier b; b.bar = bar; b.x = xb_xcc_id(); b.st = st;
    if (threadIdx.x == 0) (void)xb_add(&bar[XB_XCNT(b.x)], 1u);
    return b;
}
DI void xcd_barrier_complete(unsigned* bar, unsigned x, unsigned& nloc, unsigned& nx) {
    const unsigned G = gridDim.x * gridDim.y * gridDim.z;
    unsigned sum, cnt, mine, sp = 0u;
    for (;;) {
        sum = 0u; cnt = 0u; mine = 0u;
#pragma unroll
        for (unsigned j = 0; j < 16; ++j) { const unsigned c = xb_ld(&bar[XB_XCNT(j)]); sum += c; cnt += (c > 0u) ? 1u : 0u; mine = (j == x) ? c : mine; }
        if (sum == G) break;
        __builtin_amdgcn_s_sleep(1);
        if ((++sp & 255u) == 0u) { if (xb_ld(&bar[XB_TMO])) break; if (sp > XB_SPIN_CAP) { atomicAdd(&bar[XB_TMO], 1u); break; } }
    }
    nloc = mine > 0u ? mine : 1u; nx = cnt > 0u ? cnt : 1u;
}
DI void xcd_barrier(const XcdBarrier& b, const bool leader  ) {
    asm volatile("s_waitcnt vmcnt(0)" ::: "memory");
    __syncthreads();
    if (leader) {
        unsigned* bar = b.bar;
        __builtin_amdgcn_s_waitcnt(0);
        unsigned nloc = b.st[0], nx = b.st[1];
        if (nloc == 0u) { xcd_barrier_complete(bar, b.x, nloc, nx); b.st[0] = nloc; b.st[1] = nx; }
        const unsigned old = xb_add(&bar[XB_XSUB(b.x)], 1u);
        const unsigned gen = old / nloc;
        if (old + 1u == (gen + 1u) * nloc) {
            __builtin_amdgcn_fence(__ATOMIC_RELEASE, "agent");
            asm volatile("s_waitcnt vmcnt(0)" ::: "memory");
            const unsigned og = xb_add(&bar[XB_TOP], 1u);
            asm volatile("buffer_inv sc1" ::: "memory");
            const unsigned tg = og / nx;
            if (og + 1u == (tg + 1u) * nx) xb_add(&bar[XB_TOPGEN], 1u);
            else XB_SPIN(xb_ld(&bar[XB_TOPGEN]) == tg, bar);
            asm volatile("s_waitcnt vmcnt(0)" ::: "memory");
            __builtin_amdgcn_fence(__ATOMIC_ACQUIRE, "workgroup");
            xb_add(&bar[XB_XGEN(b.x)], 1u);
            asm volatile("s_waitcnt vmcnt(0)" ::: "memory");
        } else {
            asm volatile("buffer_inv sc1" ::: "memory");
            XB_SPIN(xb_ld(&bar[XB_XGEN(b.x)]) == gen, bar);
            asm volatile("s_waitcnt vmcnt(0)" ::: "memory");
            __builtin_amdgcn_fence(__ATOMIC_ACQUIRE, "workgroup");
        }
    }
    __syncthreads();
}

namespace pg8 {
constexpr int BM = 256, BK = 64, HALF = 128, HTB = HALF * BK * 2, STAGE_BYTES = 8 * HTB;
constexpr int IDXT_OFF = STAGE_BYTES + 8192;
__host__ __device__ __forceinline__ int lds_byte(int r, int c) { const int st = (r >> 4) * 2 + (c >> 5), rr = r & 15, cc = c & 31, ob = rr * 64 + cc * 2; return st * 1024 + (ob ^ (((ob >> 9) & 1) << 5)); }
__host__ __device__ __forceinline__ void stage_rc(int b, int& R, int& C) { const int st = b / 1024, sb = b % 1024, swz = sb ^ (((sb >> 9) & 1) << 5); R = (st >> 1) * 16 + swz / 64; C = (st & 1) * 32 + (swz % 64) / 2; }
__host__ __device__ __forceinline__ int perm32(int rho) { const int n = rho >> 4, i = rho & 15; return 8 * (i >> 2) + 4 * n + (i & 3); }

struct Unit { const char* A; const int* rows; const char* Bt; int arow; int orow; int pn; int aux; };

template <class Epi, class Sched>
DI void gemm_phase(LAS unsigned char* lds, const int tid, const int K, const unsigned lda_bytes, const Sched& S, const Epi& E) {
    const int wid = __builtin_amdgcn_readfirstlane(tid >> 6), lane = tid & 63, wr = wid >> 2, wc = wid & 3, fr = lane & 15, fq = lane >> 4;
    const int nt = K / BK;
    unsigned voffB[2], cofA[2]; int rsel[2];
#pragma unroll
    for (int i = 0; i < 2; ++i) { int R, C; stage_rc(tid * 16 + i * 8192, R, C); const int Rb = Epi::PERM ? ((R & ~31) + perm32(R & 31)) : R;
        voffB[i] = (unsigned)(Rb * K + C) * 2u; cofA[i] = (unsigned)C * 2u; rsel[i] = R; }
    const size_t kstep = (size_t)(BK * 2);
    const size_t hstep = (size_t)HALF * K * 2;
    const unsigned ldsw = (unsigned)wid * 1024u;
    const int aoff = lds_byte(wr * 64 + fr, fq * 8), boff = lds_byte(wc * 32 + fr, fq * 8);
#define PG8_SA(b, h) (((b) * 2 + (h)) * HTB)
#define PG8_SB(b, h) ((4 + (b) * 2 + (h)) * HTB)
#define PG8_STAGE(bufoff, gbase, voff) do { _Pragma("unroll") for (int _i = 0; _i < 2; ++_i) \
        __builtin_amdgcn_global_load_lds((const unsigned*)((const char*)(gbase) + (voff)[_i]), (LAS unsigned*)(lds + (bufoff) + ldsw + _i * 8192), 16, 0, 0); } while (0)
#define PG8_LDA(dst, b, h) do { _Pragma("unroll") for (int m = 0; m < 4; ++m) _Pragma("unroll") for (int k = 0; k < 2; ++k) dst[m][k] = *(const LAS bf16x8*)(lds + PG8_SA(b, h) + aoff + m * 2048 + k * 1024); } while (0)
#define PG8_LDB(dst, b, h) do { _Pragma("unroll") for (int n = 0; n < 2; ++n) _Pragma("unroll") for (int k = 0; k < 2; ++k) dst[n][k] = *(const LAS bf16x8*)(lds + PG8_SB(b, h) + boff + n * 2048 + k * 1024); } while (0)
#define PG8_MMA(ai, bj, At, Bt) do { __builtin_amdgcn_s_setprio(1); _Pragma("unroll") for (int m = 0; m < 4; ++m) _Pragma("unroll") for (int n = 0; n < 2; ++n) _Pragma("unroll") for (int k = 0; k < 2; ++k) \
        acc[ai][bj][m][n] = __builtin_amdgcn_mfma_f32_16x16x32_bf16(Bt[n][k], At[m][k], acc[ai][bj][m][n], 0, 0, 0); __builtin_amdgcn_s_setprio(0); } while (0)
#define PG8_WAIT_V(n) asm volatile("s_waitcnt vmcnt(" #n ")" ::: "memory")
#define PG8_WAIT_L(n) asm volatile("s_waitcnt lgkmcnt(" #n ")" ::: "memory")
#define PG8_BAR __builtin_amdgcn_s_barrier()
#define PG8_SCHED __builtin_amdgcn_sched_barrier(0)
    Unit cur, nxt; int ui = 0;
    if (!S.next(0, cur)) return;
    f32x4 acc[2][2][4][2];
#pragma unroll
    for (int a = 0; a < 2; ++a)
#pragma unroll
        for (int b = 0; b < 2; ++b)
#pragma unroll
            for (int m = 0; m < 4; ++m)
#pragma unroll
                for (int n = 0; n < 2; ++n) acc[a][b][m][n] = (f32x4){0.f, 0.f, 0.f, 0.f};
    bf16x8 At[4][2], B0[2][2], B1[2][2];
    unsigned vA0[2], vA1[2], o0[2], o1[2];
    LAS int* idxt = (LAS int*)(lds + IDXT_OFF);
#define PG8_IDX_DMA(u, slot) do { if (wid < 4) __builtin_amdgcn_global_load_lds((const unsigned*)((u).rows + wid * 64 + lane), (LAS unsigned*)(idxt + (slot) * 256 + wid * 64), 4, 0, 0); } while (0)
    if constexpr (Sched::GATHER) {
        PG8_IDX_DMA(cur, 0);
        asm volatile("s_waitcnt vmcnt(0)" ::: "memory"); __builtin_amdgcn_s_barrier();
#pragma unroll
        for (int i = 0; i < 2; ++i) { vA0[i] = (unsigned)idxt[rsel[i]] * lda_bytes + cofA[i]; vA1[i] = (unsigned)idxt[HALF + rsel[i]] * lda_bytes + cofA[i]; }
    } else {
#pragma unroll
        for (int i = 0; i < 2; ++i) { vA0[i] = (unsigned)(cur.arow + rsel[i]) * lda_bytes + cofA[i]; vA1[i] = vA0[i] + (unsigned)HALF * lda_bytes; }
    }
    const char* cA = cur.A; const char* cB = cur.Bt;
    PG8_STAGE(PG8_SB(0, 0), cB, voffB); PG8_STAGE(PG8_SB(0, 1), cB + hstep, voffB); PG8_STAGE(PG8_SA(0, 0), cA, vA0); PG8_STAGE(PG8_SA(0, 1), cA, vA1);
    if (wr == 1) PG8_BAR;
    PG8_WAIT_V(2); PG8_BAR;
    PG8_STAGE(PG8_SB(1, 0), cB + kstep, voffB); PG8_STAGE(PG8_SA(1, 0), cA + kstep, vA0); PG8_STAGE(PG8_SB(1, 1), cB + hstep + kstep, voffB);
    PG8_WAIT_V(6); PG8_BAR;
#pragma unroll 1
    for (;;) {
        const bool has_next = S.next(ui + 1, nxt);
        const char* nA = has_next ? nxt.A : cA; const char* nB = has_next ? nxt.Bt : cB;
        if constexpr (Sched::GATHER) { if (has_next) PG8_IDX_DMA(nxt, (ui + 1) & 1); }
#pragma unroll 1
        for (int t = 0; t < nt; t += 2) {
            const bool last = (t == nt - 2);
            const char* a1 = cA + (size_t)(t + 1) * kstep;
            const char* a2 = last ? nA : cA + (size_t)(t + 2) * kstep; const char* b2 = last ? nB : cB + (size_t)(t + 2) * kstep;
            const char* a3 = a2 + kstep; const char* b3 = b2 + kstep;
#pragma unroll
            for (int i = 0; i < 2; ++i) { o0[i] = vA0[i]; o1[i] = vA1[i]; }
            if (last && has_next) {
                if constexpr (Sched::GATHER) {
#pragma unroll
                    for (int i = 0; i < 2; ++i) { o0[i] = (unsigned)idxt[((ui + 1) & 1) * 256 + rsel[i]] * lda_bytes + cofA[i]; o1[i] = (unsigned)idxt[((ui + 1) & 1) * 256 + HALF + rsel[i]] * lda_bytes + cofA[i]; }
                } else {
#pragma unroll
                    for (int i = 0; i < 2; ++i) { o0[i] = (unsigned)(nxt.arow + rsel[i]) * lda_bytes + cofA[i]; o1[i] = o0[i] + (unsigned)HALF * lda_bytes; }
                }
            }
            PG8_LDB(B0, 0, 0); PG8_LDB(B1, 0, 1); PG8_SCHED; PG8_LDA(At, 0, 0); PG8_STAGE(PG8_SA(1, 1), a1, vA1);
            PG8_WAIT_V(8); PG8_WAIT_L(0); PG8_BAR; PG8_MMA(0, 0, At, B0); PG8_MMA(0, 1, At, B1); PG8_BAR; PG8_SCHED;
            PG8_LDA(At, 0, 1); PG8_STAGE(PG8_SB(0, 0), b2, voffB); PG8_STAGE(PG8_SB(0, 1), b2 + hstep, voffB); PG8_STAGE(PG8_SA(0, 0), a2, o0);
            PG8_WAIT_V(8); PG8_WAIT_L(0); PG8_BAR; PG8_MMA(1, 0, At, B0); PG8_MMA(1, 1, At, B1); PG8_BAR; PG8_SCHED;
            PG8_LDB(B0, 1, 0); PG8_LDB(B1, 1, 1); PG8_SCHED; PG8_LDA(At, 1, 0); PG8_STAGE(PG8_SA(0, 1), a2, o1);
            PG8_WAIT_V(8); PG8_WAIT_L(0); PG8_BAR; PG8_MMA(0, 0, At, B0); PG8_MMA(0, 1, At, B1); PG8_BAR; PG8_SCHED;
            PG8_LDA(At, 1, 1); PG8_STAGE(PG8_SB(1, 0), b3, voffB); PG8_STAGE(PG8_SB(1, 1), b3 + hstep, voffB); PG8_STAGE(PG8_SA(1, 0), a3, o0);
            PG8_WAIT_V(8); PG8_WAIT_L(0); PG8_BAR; PG8_MMA(1, 0, At, B0); PG8_MMA(1, 1, At, B1); PG8_BAR; PG8_SCHED;
        }
        if (wr == 0) PG8_BAR;
        E(acc, cur, wr, wc, fr, fq);
        if (!has_next) break;
#pragma unroll
        for (int a = 0; a < 2; ++a)
#pragma unroll
            for (int b = 0; b < 2; ++b)
#pragma unroll
                for (int m = 0; m < 4; ++m)
#pragma unroll
                    for (int n = 0; n < 2; ++n) acc[a][b][m][n] = (f32x4){0.f, 0.f, 0.f, 0.f};
        cur = nxt; cA = nA; cB = nB; ++ui;
#pragma unroll
        for (int i = 0; i < 2; ++i) { vA0[i] = o0[i]; vA1[i] = o1[i]; }
        if (wr == 1) PG8_BAR;
    }
    PG8_WAIT_V(0);
    PG8_BAR;
#undef PG8_IDX_DMA
#undef PG8_SA
#undef PG8_SB
#undef PG8_STAGE
#undef PG8_LDA
#undef PG8_LDB
#undef PG8_MMA
#undef PG8_WAIT_V
#undef PG8_WAIT_L
#undef PG8_BAR
#undef PG8_SCHED
}
}
using pg8::Unit;

DI int crow(int reg, int h) { return (reg & 3) + 8 * (reg >> 2) + 4 * h; }
template <int KW> DI void block_gemm32(LAS unsigned char* lds, const char* Ap, size_t lda, const char* Bp, size_t ldb, int wid, int lane, float (&x2)[2]) {
    const int r = lane & 31, h = lane >> 5;
    const char* a = Ap + (size_t)r * lda + (size_t)wid * KW * 2 + h * 16; const char* b = Bp + (size_t)r * ldb + (size_t)wid * KW * 2 + h * 16;
    bf16x8 av[KW / 16], bv[KW / 16];
#pragma unroll
    for (int s = 0; s < KW / 16; ++s) { av[s] = *(const bf16x8*)(a + s * 32); bv[s] = *(const bf16x8*)(b + s * 32); }
    f32x16 acc;
#pragma unroll
    for (int i = 0; i < 16; ++i) acc[i] = 0.f;
#pragma unroll
    for (int s = 0; s < KW / 16; ++s) acc = __builtin_amdgcn_mfma_f32_32x32x16_bf16(av[s], bv[s], acc, 0, 0, 0);
    LAS float* P = (LAS float*)lds;
#pragma unroll
    for (int i = 0; i < 16; ++i) P[(wid * 16 + i) * 64 + lane] = acc[i];
    __syncthreads();
#pragma unroll
    for (int ii = 0; ii < 2; ++ii) { float sum = 0.f;
#pragma unroll
        for (int p = 0; p < 8; ++p) sum += P[(p * 16 + 2 * wid + ii) * 64 + lane];
        x2[ii] = sum; }
    __syncthreads();
}

struct DenseSched {
    static constexpr bool GATHER = false;
    int nM, nN, nwg, G, c; const char* A; const int* iota; const char* Bt; int K; bool gates;
    DI void init(int nN_, int G_, int c_, const char* A_, const int* iota_, const char* Bt_, int K_, bool gates_) { nM = MR / 256; nN = nN_; nwg = nM * nN; G = G_; c = c_; A = A_; iota = iota_; Bt = Bt_; K = K_; gates = gates_; }
    DI bool next(int i, Unit& u) const {
        const long L = (long)i * G + c; if (L >= nwg) return false;
        int wgid = (int)L; { const int q = nwg / 8, r = nwg % 8, xcd = wgid % 8, off = wgid / 8; wgid = (xcd < r ? xcd * (q + 1) : r * (q + 1) + (xcd - r) * q) + off; }
        const int nig = 8 * nN, gid = wgid / nig, fm = gid * 8, gsz = (nM - fm) < 8 ? (nM - fm) : 8;
        const int pm = fm + ((wgid % nig) % gsz), pn = (wgid % nig) / gsz;
        u.A = A + (gates ? (size_t)(pn >> 1) * 512 : (size_t)0); u.rows = nullptr; u.arow = pm * 256; u.Bt = Bt + (size_t)pn * 256 * K * 2; u.orow = pm * 256; u.pn = pn; u.aux = 0;
        return true;
    }
};
template <bool DOWN> struct ExpertSched {
    static constexpr bool GATHER = !DOWN;
    static constexpr int NPN = DOWN ? 4 : 2, K = DOWN ? 256 : 1024, TPX = 32 / NPN, PER_ROUND = 8 * TPX;
    static constexpr size_t WSTRIDE = DOWN ? (size_t)1024 * 256 * 2 : (size_t)512 * 1024 * 2;
    int c, nrt; LAS const int* tile_e; const char* ws; const char* Wr; const char* Ws;
    DI bool next(int i, Unit& u) const {
        const int x = c & 7, s = c >> 3;
        const int tile = i * PER_ROUND + x * TPX + s / NPN, pn = s % NPN;
        if (tile >= nrt + N_SH_TILES) return false;
        u.A = ws + (DOWN ? WS_ACT : WS_HB); u.pn = pn;
        const int* iota = (const int*)(ws + WS_IOTA);
        if (tile < nrt) { const int e = __builtin_amdgcn_readfirstlane(tile_e[tile]); u.aux = e; u.orow = tile * 256; u.arow = u.orow; u.rows = DOWN ? nullptr : (const int*)(ws + WS_ROWTOK) + tile * 256; u.Bt = Wr + (size_t)e * WSTRIDE + (size_t)pn * 256 * K * 2; }
        else { const int t2 = tile - nrt; u.aux = -1; u.orow = SH_BASE + t2 * 256; u.arow = u.orow; u.rows = DOWN ? nullptr : iota + t2 * 256; u.Bt = Ws + (size_t)pn * 256 * K * 2; }
        return true;
    }
};

struct EpiWin {
    static constexpr bool PERM = true;
    bf16_t* YB; bf16_t* XR; const float* bias;
    DI void operator()(const f32x4 (&acc)[2][2][4][2], const Unit& u, int wr, int wc, int fr, int fq) const {
        const bool isy = u.pn < 4; bf16_t* base = isy ? YB : XR;
        const int colo = (isy ? u.pn : u.pn - 4) * 256 + wc * 32 + 8 * fq, bcol = u.pn * 256 + wc * 32 + 8 * fq;
        f32x4 bv[2][2];
#pragma unroll
        for (int bj = 0; bj < 2; ++bj)
#pragma unroll
            for (int n = 0; n < 2; ++n) bv[bj][n] = *(const f32x4*)(bias + bcol + bj * 128 + 4 * n);
#pragma unroll
        for (int ai = 0; ai < 2; ++ai)
#pragma unroll
            for (int m = 0; m < 4; ++m) { bf16_t* rowp = base + (size_t)(u.orow + ai * 128 + wr * 64 + m * 16 + fr) * 1024 + colo;
#pragma unroll
                for (int bj = 0; bj < 2; ++bj) { f32x4 v0 = acc[ai][bj][m][0] + bv[bj][0], v1 = acc[ai][bj][m][1] + bv[bj][1];
                    if (isy) {
#pragma unroll
                        for (int j = 0; j < 4; ++j) { v0[j] = gelu_tanh(v0[j]); v1[j] = gelu_tanh(v1[j]); } }
                    u32x4 w; w.x = pk_bf16(v0[0], v0[1]); w.y = pk_bf16(v0[2], v0[3]); w.z = pk_bf16(v1[0], v1[1]); w.w = pk_bf16(v1[2], v1[3]);
                    *(u32x4*)(rowp + bj * 128) = w; } }
    }
};
struct EpiGates {
    static constexpr bool PERM = false;
    unsigned* AB; const bf16_t* XC; const float* bg; const float* c8;
    DI void operator()(const f32x4 (&acc)[2][2][4][2], const Unit& u, int wr, int wc, int fr, int fq) const {
        const int nb = u.pn >> 1, ph = u.pn & 1;
#pragma unroll
        for (int n = 0; n < 2; ++n) {
            const int cl = ph * 128 + wc * 32 + 16 * n + 4 * fq;
            const int ch = nb * 256 + cl;
            const f32x4 bgx = *(const f32x4*)(bg + nb * 512 + cl), bga = *(const f32x4*)(bg + nb * 512 + 256 + cl), cc = *(const f32x4*)(c8 + ch);
            u32x2 xpv[2][4];
#pragma unroll
            for (int ai = 0; ai < 2; ++ai)
#pragma unroll
                for (int m = 0; m < 4; ++m) xpv[ai][m] = *(const u32x2*)(XC + (size_t)(u.orow + ai * 128 + wr * 64 + m * 16 + fr) * 1024 + ch);
            asm volatile("" ::: "memory");
#pragma unroll
            for (int ai = 0; ai < 2; ++ai)
#pragma unroll
                for (int m = 0; m < 4; ++m) {
                    const size_t row = (size_t)(u.orow + ai * 128 + wr * 64 + m * 16 + fr);
                    const u32x2 xp = xpv[ai][m];
                    const float xc[4] = {bflo(xp.x), bfhi(xp.x), bflo(xp.y), bfhi(xp.y)};
                    u32x4 w4;
#pragma unroll
                    for (int j = 0; j < 4; ++j) { float a, b; lru_gate(acc[ai][0][m][n][j] + bgx[j], acc[ai][1][m][n][j] + bga[j], xc[j], cc[j], a, b); w4[j] = pk_bf16(a, b); }
                    *(u32x4*)(AB + row * 1024 + ch) = w4;
                    asm volatile("" ::: "memory");
                }
        }
    }
};
struct EpiResid {
    static constexpr bool PERM = true;
    bf16_t* V; const float* x; const bf16_t* HB; const bf16_t* HLO;
    DI void operator()(const f32x4 (&acc)[2][2][4][2], const Unit& u, int wr, int wc, int fr, int fq) const {
        const int col0 = u.pn * 256 + wc * 32 + 8 * fq;
#pragma unroll
        for (int ai = 0; ai < 2; ++ai)
#pragma unroll
            for (int m = 0; m < 4; ++m) { const size_t ro = (size_t)(u.orow + ai * 128 + wr * 64 + m * 16 + fr) * 1024 + col0;
#pragma unroll
                for (int bj = 0; bj < 2; ++bj) {
                    float h[8];
                    if (x) { const f32x4 h0 = *(const f32x4*)(x + ro + bj * 128), h1 = *(const f32x4*)(x + ro + bj * 128 + 4); h[0] = h0[0]; h[1] = h0[1]; h[2] = h0[2]; h[3] = h0[3]; h[4] = h1[0]; h[5] = h1[1]; h[6] = h1[2]; h[7] = h1[3]; }
                    else res8(*(const u32x4*)(HB + ro + bj * 128), *(const u32x4*)(HLO + ro + bj * 128), h);
                    const f32x4 a0 = acc[ai][bj][m][0], a1 = acc[ai][bj][m][1];
                    u32x4 w; w.x = pk_bf16(h[0] * ALPHA + a0[0], h[1] * ALPHA + a0[1]); w.y = pk_bf16(h[2] * ALPHA + a0[2], h[3] * ALPHA + a0[3]);
                    w.z = pk_bf16(h[4] * ALPHA + a1[0], h[5] * ALPHA + a1[1]); w.w = pk_bf16(h[6] * ALPHA + a1[2], h[7] * ALPHA + a1[3]);
                    *(u32x4*)(V + ro + bj * 128) = w; } }
    }
};
struct EpiQkv {
    static constexpr bool PERM = true;
    bf16_t* Q; bf16_t* KV;
    DI void operator()(const f32x4 (&acc)[2][2][4][2], const Unit& u, int wr, int wc, int fr, int fq) const {
        const bool isq = u.pn < 4; bf16_t* base = isq ? Q : KV; const int ld = isq ? 1024 : 512;
        const int col0 = (isq ? u.pn : u.pn - 4) * 256 + wc * 32 + 8 * fq;
#pragma unroll
        for (int ai = 0; ai < 2; ++ai)
#pragma unroll
            for (int m = 0; m < 4; ++m) { bf16_t* rowp = base + (size_t)(u.orow + ai * 128 + wr * 64 + m * 16 + fr) * ld + col0;
#pragma unroll
                for (int bj = 0; bj < 2; ++bj) { const f32x4 v0 = acc[ai][bj][m][0], v1 = acc[ai][bj][m][1];
                    u32x4 w; w.x = pk_bf16(v0[0], v0[1]); w.y = pk_bf16(v0[2], v0[3]); w.z = pk_bf16(v1[0], v1[1]); w.w = pk_bf16(v1[2], v1[3]);
                    *(u32x4*)(rowp + bj * 128) = w; } }
    }
};
struct EpiGu {
    static constexpr bool PERM = true;
    bf16_t* ACT; const float* roww;
    DI void operator()(const f32x4 (&acc)[2][2][4][2], const Unit& u, int wr, int wc, int fr, int fq) const {
        const int col0 = u.pn * 128 + wc * 32 + 8 * fq;
        float w8[2][4];
#pragma unroll
        for (int ai = 0; ai < 2; ++ai)
#pragma unroll
            for (int m = 0; m < 4; ++m) w8[ai][m] = (u.aux >= 0) ? roww[u.orow + ai * 128 + wr * 64 + m * 16 + fr] : 1.0f;
#pragma unroll
        for (int ai = 0; ai < 2; ++ai)
#pragma unroll
            for (int m = 0; m < 4; ++m) { const int row = u.orow + ai * 128 + wr * 64 + m * 16 + fr;
                bf16_t* rowp = ACT + (size_t)row * 256 + col0;
                float v[8];
#pragma unroll
                for (int n = 0; n < 2; ++n)
#pragma unroll
                    for (int j = 0; j < 4; ++j) v[n * 4 + j] = silu_mul(acc[ai][0][m][n][j], acc[ai][1][m][n][j]) * w8[ai][m];
                u32x4 w; w.x = pk_bf16(v[0], v[1]); w.y = pk_bf16(v[2], v[3]); w.z = pk_bf16(v[4], v[5]); w.w = pk_bf16(v[6], v[7]);
                *(u32x4*)rowp = w; }
    }
};

constexpr int LDS_MISC = pg8::STAGE_BYTES;
constexpr int LDS_BYTES = LDS_MISC + 24576;
typedef const __attribute__((address_space(4))) unsigned long long* KArgPtr;
struct Ctx { KArgPtr kp; LAS unsigned char* lds; int G, blk, tid, wid, lane; };
#define GPTR(T, v) ((T)(__attribute__((address_space(1))) char*)(v))
DI Params load_params(KArgPtr k) {
    Params p;
    p.x = GPTR(const float*, k[0]); p.meta = GPTR(const float*, k[1]); p.rg_w_in = GPTR(const float*, k[2]); p.rg_b_in = GPTR(const float*, k[3]); p.rg_conv_w = GPTR(const float*, k[4]); p.rg_conv_b = GPTR(const float*, k[5]);
    p.rg_w_gates = GPTR(const float*, k[6]); p.rg_b_gates = GPTR(const float*, k[7]); p.rg_a_param = GPTR(const float*, k[8]); p.rg_w_out = GPTR(const float*, k[9]); p.attn_w_qkv = GPTR(const float*, k[10]); p.attn_sinks = GPTR(const float*, k[11]);
    p.attn_w_o = GPTR(const float*, k[12]); p.rel_table = GPTR(const float*, k[13]); p.ln_gain = GPTR(const float*, k[14]); p.ln_bias = GPTR(const float*, k[15]); p.router_w = GPTR(const float*, k[16]); p.router_bias = GPTR(const float*, k[17]);
    p.ex_w_gu = GPTR(const float*, k[18]); p.ex_w_down = GPTR(const float*, k[19]); p.sh_w_gu = GPTR(const float*, k[20]); p.sh_w_down = GPTR(const float*, k[21]); p.out = GPTR(float*, k[22]); p.ws = GPTR(char*, k[23]);
    return p;
}

DI void tr_tile(const float* src, int N, int k0, int n0, float scale, bf16_t* dst_row0  , int K, bf16_t* dst_lo, LAS bf16_t* T, int lane) {
#pragma unroll 4
    for (int it = 0; it < 8; ++it) {
        const int kk = it * 8 + 2 * (lane >> 4), c4 = (lane & 15) * 4;
        const f32x4 v0 = *(const f32x4*)(src + (size_t)(k0 + kk) * N + n0 + c4) * scale, v1 = *(const f32x4*)(src + (size_t)(k0 + kk + 1) * N + n0 + c4) * scale;
#pragma unroll
        for (int j = 0; j < 4; ++j) *(LAS unsigned*)(T + (c4 + j) * 72 + kk) = pk_bf16(v0[j], v1[j]);
    }
    __builtin_amdgcn_s_waitcnt(0xc07f);
#pragma unroll 4
    for (int it = 0; it < 8; ++it) {
        const int n = it * 8 + (lane >> 3), kc = (lane & 7) * 8;
        const u32x4 w = *(const LAS u32x4*)(T + n * 72 + kc);
        *(u32x4*)(dst_row0 + (size_t)n * K + kc) = w;
    }
    if (dst_lo) {
        __builtin_amdgcn_s_waitcnt(0xc07f);
#pragma unroll 4
        for (int it = 0; it < 8; ++it) {
            const int kk = it * 8 + 2 * (lane >> 4), c4 = (lane & 15) * 4;
            const f32x4 v0 = *(const f32x4*)(src + (size_t)(k0 + kk) * N + n0 + c4) * scale, v1 = *(const f32x4*)(src + (size_t)(k0 + kk + 1) * N + n0 + c4) * scale;
#pragma unroll
            for (int j = 0; j < 4; ++j) { const unsigned hi = pk_bf16(v0[j], v1[j]); *(LAS unsigned*)(T + (c4 + j) * 72 + kk) = pk_bf16(v0[j] - bflo(hi), v1[j] - bfhi(hi)); }
        }
        __builtin_amdgcn_s_waitcnt(0xc07f);
#pragma unroll 4
        for (int it = 0; it < 8; ++it) {
            const int n = it * 8 + (lane >> 3), kc = (lane & 7) * 8;
            const u32x4 w = *(const LAS u32x4*)(T + n * 72 + kc);
            *(u32x4*)(dst_lo + (size_t)n * K + kc) = w;
        }
    }
    __builtin_amdgcn_s_waitcnt(0xc07f);
}
struct Job { const float* src; bf16_t* dst; int count, K, N, mode; };
DI int pair_perm512(int n) { return ((n & 255) >> 7) * 256 + (n >> 8) * 128 + (n & 127); }

DI void phase_prologue(const Ctx& c) {
    const Params p = load_params(c.kp); char* ws = p.ws;
    LAS bf16_t* T = (LAS bf16_t*)(c.lds) + c.wid * (64 * 72);
    const int gw = c.blk * 8 + c.wid, nw = c.G * 8;
#pragma unroll 1
    for (int j = 0; j < 10; ++j) {
        Job jb;
        switch (j) {
            case 0: jb = Job{p.rg_w_in, (bf16_t*)(ws + WS_WIN), 2, 1024, 2048, 0}; break;
            case 1: jb = Job{p.rg_w_gates, (bf16_t*)(ws + WS_WG), 8, 256, 512, 1}; break;
            case 2: jb = Job{p.rg_w_out, (bf16_t*)(ws + WS_WOUT), 2, 1024, 1024, 0}; break;
            case 3: jb = Job{p.attn_w_qkv, (bf16_t*)(ws + WS_WQKV), 2, 1024, 1536, 2}; break;
            case 4: jb = Job{p.attn_w_o, (bf16_t*)(ws + WS_WO), 2, 1024, 1024, 0}; break;
            case 5: jb = Job{p.ex_w_gu, (bf16_t*)(ws + WS_WEGU), 256, 1024, 512, 1}; break;
            case 6: jb = Job{p.ex_w_down, (bf16_t*)(ws + WS_WED), 256, 256, 1024, 0}; break;
            case 7: jb = Job{p.sh_w_gu, (bf16_t*)(ws + WS_WSGU), 4, 1024, 512, 1}; break;
            case 8: jb = Job{p.sh_w_down, (bf16_t*)(ws + WS_WSD), 4, 256, 1024, 0}; break;
            default: jb = Job{p.router_w, (bf16_t*)(ws + WS_WRH), 4, 1024, 64, 3}; break;
        }
        const int tk = jb.K / 64, tn = jb.N / 64, per = tk * tn, total = jb.count * per;
        for (int t = gw; t < total; t += nw) {
            const int mi = t / per, r = t % per, kt = r / tn, ntl = r % tn;
            const float* src = jb.src + (size_t)mi * jb.K * jb.N;
            const int n0 = ntl * 64; int drow = n0; float scale = 1.0f;
            if (jb.mode == 1) drow = pair_perm512(n0);
            if (jb.mode == 2 && n0 < 1024) scale = 0.125f;
            bf16_t* dst = jb.dst + (size_t)mi * jb.K * jb.N + (size_t)drow * jb.K + kt * 64;
            bf16_t* dlo = (jb.mode == 3) ? (bf16_t*)(ws + WS_WRL) + (size_t)mi * jb.K * jb.N + (size_t)drow * jb.K + kt * 64 : nullptr;
            tr_tile(src, jb.N, kt * 64, n0, scale, dst, jb.K, dlo, T, c.lane);
        }
    }
    const size_t gt = (size_t)c.blk * 512 + c.tid, gn = (size_t)c.G * 512;
    bf16_t* HB = (bf16_t*)(ws + WS_HB); bf16_t* HLO = (bf16_t*)(ws + WS_H);
    for (size_t i = gt; i < (size_t)MR * 128; i += gn) {
        const f32x4 a = *(const f32x4*)(p.x + i * 8), b = *(const f32x4*)(p.x + i * 8 + 4);
        u32x4 w; w.x = pk_bf16(a[0], a[1]); w.y = pk_bf16(a[2], a[3]); w.z = pk_bf16(b[0], b[1]); w.w = pk_bf16(b[2], b[3]);
        *(u32x4*)(HB + i * 8) = w;
    }
    for (size_t i = gt; i < (size_t)(MPAD - MR) * 128; i += gn) {
        const int row = MR + (int)(i / 128), c8 = (int)(i % 128) * 8;
        u32x4 w = {0u, 0u, 0u, 0u};
        if (row < NR) { const int m = (row - MR) & 15; const f32x4 a = *(const f32x4*)(p.meta + m * 1024 + c8), b = *(const f32x4*)(p.meta + m * 1024 + c8 + 4);
            w.x = pk_bf16(a[0], a[1]); w.y = pk_bf16(a[2], a[3]); w.z = pk_bf16(b[0], b[1]); w.w = pk_bf16(b[2], b[3]);
            u32x4 l; l.x = pk_bf16(a[0] - bflo(w.x), a[1] - bfhi(w.x)); l.y = pk_bf16(a[2] - bflo(w.y), a[3] - bfhi(w.y)); l.z = pk_bf16(b[0] - bflo(w.z), b[1] - bfhi(w.z)); l.w = pk_bf16(b[2] - bflo(w.w), b[3] - bfhi(w.w));
            *(u32x4*)(HLO + (size_t)row * 1024 + c8) = l; }
        *(u32x4*)(HB + (size_t)row * 1024 + c8) = w;
    }
    int* iota = (int*)(ws + WS_IOTA);
    for (size_t i = gt; i < (size_t)ROWS_ALL; i += gn) iota[i] = (int)i;
    float* C8 = (float*)(ws + WS_C8);
    for (size_t i = gt; i < 2048; i += gn) { const float L = p.rg_a_param[i]; C8[i] = -8.0f * log1pf(expf(-L)); }
}


DI void phase_win(const Ctx& c, int j  ) {
    const Params p = load_params(c.kp); char* ws = p.ws;
    const bf16_t* HB = (const bf16_t*)(ws + WS_HB); const bf16_t* W = (const bf16_t*)(ws + WS_WIN) + (size_t)j * 2048 * 1024;
    bf16_t* YB = (bf16_t*)(ws + WS_U + U_YB); bf16_t* XR = (bf16_t*)(ws + WS_U + U_XR); const float* bias = p.rg_b_in + j * 2048;
    const int mt = c.G - 1 - c.blk;
    if (mt < 64) {
        float x2[2]; block_gemm32<128>(c.lds, (const char*)(HB + (size_t)MR * 1024), 2048, (const char*)(W + (size_t)mt * 32 * 1024), 2048, c.wid, c.lane, x2);
        const int r = c.lane & 31, h = c.lane >> 5, col = mt * 32 + r; const float b = bias[col];
#pragma unroll
        for (int ii = 0; ii < 2; ++ii) { const int row = MR + crow(2 * c.wid + ii, h); const float v = x2[ii] + b;
            if (col < 1024) YB[(size_t)row * 1024 + col] = f2bf(gelu_tanh(v)); else XR[(size_t)row * 1024 + col - 1024] = f2bf(v); }
    }
    DenseSched S; S.init(8, c.G, c.blk, (const char*)HB, (const int*)(ws + WS_IOTA), (const char*)W, 1024, false);
    EpiWin E{YB, XR, bias};
    pg8::gemm_phase(c.lds, c.tid, 1024, 2048u, S, E);
}
DI void load_xr8(const bf16_t* XR, int b, int s, int c8, float (&v)[8]) {
    if (s < -NMETA) {
#pragma unroll
        for (int i = 0; i < 8; ++i) v[i] = 0.f; return; }
    const size_t row = s >= 0 ? (size_t)b * SEQ + s : (size_t)MR + b * NMETA + (s + NMETA);
    const u32x4 w = *(const u32x4*)(XR + row * 1024 + c8);
    v[0] = bflo(w.x); v[1] = bfhi(w.x); v[2] = bflo(w.y); v[3] = bfhi(w.y); v[4] = bflo(w.z); v[5] = bfhi(w.z); v[6] = bflo(w.w); v[7] = bfhi(w.w);
}
DI void phase_conv(const Ctx& c, int j) {
    const Params p = load_params(c.kp); char* ws = p.ws;
    const bf16_t* XR = (const bf16_t*)(ws + WS_U + U_XR); bf16_t* XC = (bf16_t*)(ws + WS_U + U_XC);
    const int c8 = (c.tid & 127) * 8, sub = c.tid >> 7;
    float w0[8], w1[8], w2[8], w3[8], cb[8];
#pragma unroll
    for (int i = 0; i < 8; ++i) { w0[i] = p.rg_conv_w[(j * 4 + 0) * 1024 + c8 + i]; w1[i] = p.rg_conv_w[(j * 4 + 1) * 1024 + c8 + i]; w2[i] = p.rg_conv_w[(j * 4 + 2) * 1024 + c8 + i]; w3[i] = p.rg_conv_w[(j * 4 + 3) * 1024 + c8 + i]; cb[i] = p.rg_conv_b[j * 1024 + c8 + i]; }
    for (int tile = c.blk; tile < 513; tile += c.G) {
        int b, s0;
        if (tile < 512) { b = tile >> 8; s0 = (tile & 255) * 64 + sub * 16; }
        else { if (sub >= 2) continue; b = sub; s0 = -NMETA; }
        float x3[8], x2[8], x1[8], x0[8];
        load_xr8(XR, b, s0 - 3, c8, x3); load_xr8(XR, b, s0 - 2, c8, x2); load_xr8(XR, b, s0 - 1, c8, x1);
#pragma unroll 4
        for (int k = 0; k < 16; ++k) {
            const int s = s0 + k;
            load_xr8(XR, b, s, c8, x0);
            float o[8];
#pragma unroll
            for (int i = 0; i < 8; ++i) o[i] = cb[i] + w0[i] * x3[i] + w1[i] * x2[i] + w2[i] * x1[i] + w3[i] * x0[i];
            const size_t row = s >= 0 ? (size_t)b * SEQ + s : (size_t)MR + b * NMETA + (s + NMETA);
            u32x4 w; w.x = pk_bf16(o[0], o[1]); w.y = pk_bf16(o[2], o[3]); w.z = pk_bf16(o[4], o[5]); w.w = pk_bf16(o[6], o[7]);
            *(u32x4*)(XC + row * 1024 + c8) = w;
#pragma unroll
            for (int i = 0; i < 8; ++i) { x3[i] = x2[i]; x2[i] = x1[i]; x1[i] = x0[i]; }
        }
    }
}
struct GatesSched {
    static constexpr bool GATHER = false;
    int c; const char* A; const char* Bt;
    DI bool next(int i, Unit& u) const {
        if (i >= 4) return false;
        const int T = c + 256 * (i >> 1), ph = i & 1, pm = T >> 2, nb = T & 3, cn = nb * 2 + ph;
        u.A = A + (size_t)nb * 512; u.rows = nullptr; u.arow = pm * 256; u.Bt = Bt + (size_t)cn * 256 * 256 * 2; u.orow = pm * 256; u.pn = cn; u.aux = 0;
        return true;
    }
};
DI void conv_block(const Params& p, int j, const bf16_t* XR, bf16_t* XC, int b, int s0, int ch0, int ngroups, int tid) {
    const int c8 = ch0 + (tid & 31) * 8, grp = tid >> 5;
    if (grp >= ngroups) return;
    float w0[8], w1[8], w2[8], w3[8], cb[8];
#pragma unroll
    for (int i = 0; i < 8; ++i) { w0[i] = p.rg_conv_w[(j * 4 + 0) * 1024 + c8 + i]; w1[i] = p.rg_conv_w[(j * 4 + 1) * 1024 + c8 + i]; w2[i] = p.rg_conv_w[(j * 4 + 2) * 1024 + c8 + i]; w3[i] = p.rg_conv_w[(j * 4 + 3) * 1024 + c8 + i]; cb[i] = p.rg_conv_b[j * 1024 + c8 + i]; }
    const int sb = s0 + grp * 16;
    float x3[8], x2[8], x1[8], x0[8];
    load_xr8(XR, b, sb - 3, c8, x3); load_xr8(XR, b, sb - 2, c8, x2); load_xr8(XR, b, sb - 1, c8, x1);
#pragma unroll 4
    for (int k = 0; k < 16; ++k) {
        const int s = sb + k;
        load_xr8(XR, b, s, c8, x0);
        float o[8];
#pragma unroll
        for (int i = 0; i < 8; ++i) o[i] = cb[i] + w0[i] * x3[i] + w1[i] * x2[i] + w2[i] * x1[i] + w3[i] * x0[i];
        const size_t row = s >= 0 ? (size_t)b * SEQ + s : (size_t)MR + b * NMETA + (s + NMETA);
        u32x4 w; w.x = pk_bf16(o[0], o[1]); w.y = pk_bf16(o[2], o[3]); w.z = pk_bf16(o[4], o[5]); w.w = pk_bf16(o[6], o[7]);
        *(u32x4*)(XC + row * 1024 + c8) = w;
#pragma unroll
        for (int i = 0; i < 8; ++i) { x3[i] = x2[i]; x2[i] = x1[i]; x1[i] = x0[i]; }
    }
}
DI void phase_gates(const Ctx& c, int j) {
    const Params p = load_params(c.kp); char* ws = p.ws;
    const bf16_t* XR = (const bf16_t*)(ws + WS_U + U_XR); bf16_t* XCw = (bf16_t*)(ws + WS_U + U_XC);
    const bf16_t* XC = (const bf16_t*)(ws + WS_U + U_XC); const bf16_t* W = (const bf16_t*)(ws + WS_WG) + (size_t)j * 4 * 512 * 256;
    unsigned* AB = (unsigned*)(ws + WS_U + U_AB);
    const float* bg = p.rg_b_gates + j * 2048; const float* c8 = (const float*)(ws + WS_C8) + j * 1024;
    const int mt = c.G - 1 - c.blk;
#pragma unroll 1
    for (int i = 0; i < 2; ++i) { const int T = c.blk + 256 * i, pm = T >> 2, nb = T & 3; conv_block(p, j, XR, XCw, pm >> 6, (pm & 63) * 256, nb * 256, 16, c.tid); }
    if (mt < 32) { const int nb = mt >> 3; conv_block(p, j, XR, XCw, (c.tid >> 5) & 1, -NMETA - 16 * ((c.tid >> 5) & 1), nb * 256, 2, c.tid); }
    asm volatile("s_waitcnt vmcnt(0)" ::: "memory");
    __syncthreads();
    __builtin_amdgcn_fence(__ATOMIC_ACQUIRE, "agent");
    asm volatile("s_waitcnt vmcnt(0)" ::: "memory");
    if (mt < 32) {
        const int nb = mt >> 3, ph = (mt >> 2) & 1, q = mt & 3;
        const char* Ap = (const char*)(XC + (size_t)MR * 1024 + nb * 256);
        const bf16_t* Wt = W + (size_t)(nb * 512 + ph * 256) * 256;
        float gx[2], ga[2];
        block_gemm32<32>(c.lds, Ap, 2048, (const char*)(Wt + (size_t)(q * 32) * 256), 512, c.wid, c.lane, gx);
        block_gemm32<32>(c.lds, Ap, 2048, (const char*)(Wt + (size_t)(128 + q * 32) * 256), 512, c.wid, c.lane, ga);
        const int r = c.lane & 31, h = c.lane >> 5, cl = ph * 128 + q * 32 + r, ch = nb * 256 + cl;
        const float bgx = bg[nb * 512 + cl], bga = bg[nb * 512 + 256 + cl], cc = c8[ch];
#pragma unroll
        for (int ii = 0; ii < 2; ++ii) { const size_t row = (size_t)(MR + crow(2 * c.wid + ii, h)); float a, b; lru_gate(gx[ii] + bgx, ga[ii] + bga, bf2f(XC[row * 1024 + ch]), cc, a, b);
            AB[row * 1024 + ch] = pk_bf16(a, b); }
    }
    GatesSched S; S.c = c.blk; S.A = (const char*)XC; S.Bt = (const char*)W;
    EpiGates E{AB, XC, bg, c8};
    pg8::gemm_phase(c.lds, c.tid, 256, 2048u, S, E);
    __builtin_amdgcn_fence(__ATOMIC_ACQUIRE, "agent");
    {
        const int T = c.blk + 256 * (c.tid >> 8), pm = T >> 2, nb = T & 3, ch = nb * 256 + (c.tid & 255);
        const size_t row0 = (size_t)pm * 256; f32x2* AGG = (f32x2*)(ws + WS_AGG);
        float A = 1.f, Hh = 0.f;
#pragma unroll 1
        for (int t = 0; t < 256; t += 32) {
            unsigned w[32];
#pragma unroll
            for (int k = 0; k < 32; ++k) w[k] = AB[(row0 + t + k) * 1024 + ch];
#pragma unroll
            for (int k = 0; k < 32; ++k) { const float a = __expf(bflo(w[k])); Hh = a * Hh + bfhi(w[k]); A *= a; }
        }
        AGG[(size_t)pm * 1024 + ch] = (f32x2){A, Hh};
    }
}
DI void phase_scan1(const Ctx& c) {
    char* ws = GPTR(char*, c.kp[23]);
    const unsigned* AB = (const unsigned*)(ws + WS_U + U_AB); f32x2* AGG = (f32x2*)(ws + WS_AGG);
    for (int item = c.blk; item < 256; item += c.G) {
        const int bc = item >> 1, ch = (item & 1) * 512 + c.tid;
        const size_t row0 = (size_t)bc * 256;
        float A = 1.f, Hh = 0.f;
#pragma unroll 1
        for (int t = 0; t < 256; t += 32) {
            unsigned w[32];
#pragma unroll
            for (int k = 0; k < 32; ++k) w[k] = AB[(row0 + t + k) * 1024 + ch];
#pragma unroll
            for (int k = 0; k < 32; ++k) { const float a = __expf(bflo(w[k])); Hh = a * Hh + bfhi(w[k]); A *= a; }
        }
        AGG[(size_t)bc * 1024 + ch] = (f32x2){A, Hh};
    }
}
DI void phase_scan2(const Ctx& c) {
    char* ws = GPTR(char*, c.kp[23]);
    const unsigned* AB = (const unsigned*)(ws + WS_U + U_AB); const f32x2* AGG = (const f32x2*)(ws + WS_AGG);
    const bf16_t* YB = (const bf16_t*)(ws + WS_U + U_YB); bf16_t* Z = (bf16_t*)(ws + WS_U + U_Z);
    for (int item = c.blk; item < 256; item += c.G) {
        const int bc = item >> 1, b = bc >> 6, chunk = bc & 63, ch = (item & 1) * 512 + c.tid;
        float h = 0.f;
        {
            unsigned w[NMETA]; float y[NMETA];
#pragma unroll
            for (int m = 0; m < NMETA; ++m) { const size_t row = (size_t)MR + b * NMETA + m; w[m] = AB[row * 1024 + ch]; y[m] = bf2f(YB[row * 1024 + ch]); }
#pragma unroll
            for (int m = 0; m < NMETA; ++m) { const size_t row = (size_t)MR + b * NMETA + m; h = __expf(bflo(w[m])) * h + bfhi(w[m]); if (chunk == 0) Z[row * 1024 + ch] = f2bf(y[m] * h); }
        }
#pragma unroll 1
        for (int c0 = 0; c0 < chunk; c0 += 16) {
            f32x2 g[16];
#pragma unroll
            for (int k = 0; k < 16; ++k) g[k] = (c0 + k < chunk) ? AGG[(size_t)(b * 64 + c0 + k) * 1024 + ch] : (f32x2){1.f, 0.f};
#pragma unroll
            for (int k = 0; k < 16; ++k) h = g[k].x * h + g[k].y;
        }
        const size_t row0 = (size_t)bc * 256;
#pragma unroll 1
        for (int t = 0; t < 256; t += 32) {
            unsigned w[32]; unsigned short y[32];
#pragma unroll
            for (int k = 0; k < 32; ++k) { w[k] = AB[(row0 + t + k) * 1024 + ch]; y[k] = YB[(row0 + t + k) * 1024 + ch]; }
#pragma unroll
            for (int k = 0; k < 32; ++k) { h = __expf(bflo(w[k])) * h + bfhi(w[k]); Z[(row0 + t + k) * 1024 + ch] = f2bf(bf2f(y[k]) * h); }
        }
    }
}
DI void phase_outproj(const Ctx& c, const bf16_t* A, const bf16_t* W, bool first_layer) {
    const Params p = load_params(c.kp); char* ws = p.ws;
    bf16_t* V = (bf16_t*)(ws + WS_V); const bf16_t* HB = (const bf16_t*)(ws + WS_HB); const bf16_t* HLO = (const bf16_t*)(ws + WS_H);
    const int mt = c.G - 1 - c.blk;
    if (mt < 32) {
        float x2[2]; block_gemm32<128>(c.lds, (const char*)(A + (size_t)MR * 1024), 2048, (const char*)(W + (size_t)mt * 32 * 1024), 2048, c.wid, c.lane, x2);
        const int r = c.lane & 31, h = c.lane >> 5, col = mt * 32 + r;
#pragma unroll
        for (int ii = 0; ii < 2; ++ii) { const size_t row = (size_t)(MR + crow(2 * c.wid + ii, h)); V[row * 1024 + col] = f2bf(ALPHA * (bf2f(HB[row * 1024 + col]) + bf2f(HLO[row * 1024 + col])) + x2[ii]); }
    }
    DenseSched S; S.init(4, c.G, c.blk, (const char*)A, (const int*)(ws + WS_IOTA), (const char*)W, 1024, false);
    EpiResid E{V, first_layer ? p.x : nullptr, HB, HLO};
    pg8::gemm_phase(c.lds, c.tid, 1024, 2048u, S, E);
}
DI void phase_qkv(const Ctx& c, int j) {
    const Params p = load_params(c.kp); char* ws = p.ws;
    const bf16_t* HB = (const bf16_t*)(ws + WS_HB); const bf16_t* W = (const bf16_t*)(ws + WS_WQKV) + (size_t)j * 1536 * 1024;
    bf16_t* Q = (bf16_t*)(ws + WS_U + U_QB); bf16_t* KV = (bf16_t*)(ws + WS_U + U_KV);
    const int mt = c.G - 1 - c.blk;
    if (mt < 48) {
        float x2[2]; block_gemm32<128>(c.lds, (const char*)(HB + (size_t)MR * 1024), 2048, (const char*)(W + (size_t)mt * 32 * 1024), 2048, c.wid, c.lane, x2);
        const int r = c.lane & 31, h = c.lane >> 5, col = mt * 32 + r;
#pragma unroll
        for (int ii = 0; ii < 2; ++ii) { const size_t row = (size_t)(MR + crow(2 * c.wid + ii, h)); const bf16_t v = f2bf(x2[ii]);
            if (col < 1024) Q[row * 1024 + col] = v; else KV[row * 512 + col - 1024] = v; }
    }
    DenseSched S; S.init(6, c.G, c.blk, (const char*)HB, (const int*)(ws + WS_IOTA), (const char*)W, 1024, false);
    EpiQkv E{Q, KV};
    pg8::gemm_phase(c.lds, c.tid, 1024, 2048u, S, E);
}
constexpr int AT_KP = 72, AT_VP = 296;
constexpr int AT_K_OFF = 0, AT_V_OFF = 288 * AT_KP * 2, AT_B_OFF = AT_V_OFF + 64 * AT_VP * 2;
DI bf16x8 pack_step(const f32x16& x, int s) {
    u32x4 p;
    p.x = pk_bf16(x[8 * s], x[8 * s + 1]); p.y = pk_bf16(x[8 * s + 2], x[8 * s + 3]); p.z = pk_bf16(x[8 * s + 4], x[8 * s + 5]); p.w = pk_bf16(x[8 * s + 6], x[8 * s + 7]);
    return __builtin_bit_cast(bf16x8, p);
}
DI void phase_attn(const Ctx& c, int j) {
    const Params p = load_params(c.kp); char* ws = p.ws;
    const bf16_t* Q = (const bf16_t*)(ws + WS_U + U_QB); const bf16_t* KV = (const bf16_t*)(ws + WS_U + U_KV);
    bf16_t* O = (bf16_t*)(ws + WS_U + U_OB);
    LAS bf16_t* KI = (LAS bf16_t*)(c.lds + AT_K_OFF); LAS bf16_t* VT = (LAS bf16_t*)(c.lds + AT_V_OFF); LAS float* BT = (LAS float*)(c.lds + AT_B_OFF); LAS float* BTX = (LAS float*)(c.lds + AT_B_OFF + 2560);
    const int lane = c.lane, r = lane & 31, h = lane >> 5, g = c.wid >> 1, qh = c.wid & 1;
    const bool tables_once = (c.G & 3) == 0;
    if (tables_once) { const int hk = c.blk & 3;
        for (int i = c.tid; i < 4 * 160; i += 512) { const int gg = i / 160, d = i % 160; BT[i] = p.rel_table[kBucket[d] * 16 + hk * 4 + gg]; }
        for (int i = c.tid; i < 4 * 448; i += 512) { const int gg = i / 448, d = i % 448 - 160; BTX[i] = (d >= 0 && d < 128) ? p.rel_table[kBucket[d] * 16 + hk * 4 + gg] : -1e30f; } }
    for (int item = c.blk; item < 1032; item += c.G) {
        const bool ismeta = item >= 1024;
        int b, n, hk;
        if (!ismeta) { hk = item & 3; n = (item >> 2) & 127; b = item >> 9; } else { hk = item & 3; b = (item - 1024) >> 2; n = -1; }
        const int head = hk * 4 + g;
        bf16x8 qf[2][4];
        int qi[2];
#pragma unroll
        for (int cb = 0; cb < 2; ++cb) {
            qi[cb] = qh * 64 + cb * 32 + r;
            size_t qrow;
            if (!ismeta) qrow = (size_t)b * SEQ + n * 128 + qi[cb]; else qrow = (size_t)MR + b * NMETA + (qi[cb] & 15);
#pragma unroll
            for (int ks = 0; ks < 4; ++ks) qf[cb][ks] = *(const bf16x8*)(Q + qrow * 1024 + head * 64 + ks * 16 + h * 8);
        }
        {
            u32x4 kvv[5], vvv[5];
#pragma unroll
            for (int it = 0; it < 5; ++it) {
                const int ch = c.tid + 512 * it, kk = ch >> 3, d8 = (ch & 7) * 8;
                long row = -1;
                if (ch < 288 * 8) {
                    if (kk < 16) row = (long)MR + b * NMETA + kk;
                    else if (kk >= 32 && !ismeta) { const int t = n * 128 - 128 + (kk - 32); if (t >= 0) row = (long)b * SEQ + t; }
                }
                kvv[it] = (u32x4){0u, 0u, 0u, 0u}; vvv[it] = (u32x4){0u, 0u, 0u, 0u};
                if (row >= 0) { kvv[it] = *(const u32x4*)(KV + (size_t)row * 512 + hk * 64 + d8); vvv[it] = *(const u32x4*)(KV + (size_t)row * 512 + 256 + hk * 64 + d8); }
            }
            __syncthreads();
#pragma unroll
            for (int it = 0; it < 5; ++it) {
                const int ch = c.tid + 512 * it, kk = ch >> 3, d8 = (ch & 7) * 8;
                if (ch < 288 * 8) {
                    *(LAS u32x4*)(KI + kk * AT_KP + d8) = kvv[it];
                    const int kin = kk & 15, pos = (kk & ~15) | (((kin >> 2) & 1) << 3) | (((kin >> 3) & 1) << 2) | (kin & 3);
                    const unsigned vw[4] = {vvv[it].x, vvv[it].y, vvv[it].z, vvv[it].w};
#pragma unroll
                    for (int i = 0; i < 4; ++i) { VT[(d8 + 2 * i) * AT_VP + pos] = (bf16_t)(vw[i] & 0xffffu); VT[(d8 + 2 * i + 1) * AT_VP + pos] = (bf16_t)(vw[i] >> 16); }
                }
            }
        }
        if (!tables_once) {
        for (int i = c.tid; i < 4 * 160; i += 512) { const int gg = i / 160, d = i % 160; BT[i] = p.rel_table[kBucket[d] * 16 + hk * 4 + gg]; }
        for (int i = c.tid; i < 4 * 448; i += 512) { const int gg = i / 448, d = i % 448 - 160; BTX[i] = (d >= 0 && d < 128) ? p.rel_table[kBucket[d] * 16 + hk * 4 + gg] : -1e30f; } }
        __syncthreads();
        f32x16 o[2][2];
#pragma unroll
        for (int db = 0; db < 2; ++db)
#pragma unroll
            for (int cb = 0; cb < 2; ++cb)
#pragma unroll
                for (int i = 0; i < 16; ++i) o[db][cb][i] = 0.f;
        float mrun[2] = {-1e30f, -1e30f}, lrun[2] = {0.f, 0.f};
        int kt_lo, kt_hi;
        if (ismeta) { kt_lo = 1; kt_hi = 0; }
        else if (qh == 0) { kt_lo = (n == 0) ? 5 : 1; kt_hi = 6; }
        else { kt_lo = (n == 0) ? 5 : 3; kt_hi = 8; }
        const bool active = !(ismeta && qh == 1);
        if (active) {
            for (int it = 0; it <= kt_hi - kt_lo + 1; ++it) {
                const int kt = (it == 0) ? 0 : kt_lo + it - 1;
                f32x16 s[2];
#pragma unroll
                for (int cb = 0; cb < 2; ++cb)
#pragma unroll
                    for (int i = 0; i < 16; ++i) s[cb][i] = 0.f;
#pragma unroll
                for (int ks = 0; ks < 4; ++ks) {
                    const bf16x8 kf = *(const LAS bf16x8*)(KI + (kt * 32 + r) * AT_KP + ks * 16 + h * 8);
#pragma unroll
                    for (int cb = 0; cb < 2; ++cb) s[cb] = __builtin_amdgcn_mfma_f32_32x32x16_bf16(kf, qf[cb][ks], s[cb], 0, 0, 0);
                }
                bf16x8 pf[2][2];
#pragma unroll
                for (int cb = 0; cb < 2; ++cb) {
                    float tmax = -1e30f;
                    if (kt == 0) {
#pragma unroll
                        for (int i = 0; i < 16; ++i) {
                            const int kr = crow(i, h);
                            bool valid; int d;
                            if (ismeta) { d = (qi[cb] & 15) - kr; valid = (kr < 16) && d >= 0; } else { d = NMETA + n * 128 + qi[cb] - kr; valid = kr < 16; }
                            d = d < 0 ? 0 : (d > 159 ? 159 : d);
                            const float sv = valid ? s[cb][i] + BT[g * 160 + d] : -1e30f;
                            s[cb][i] = sv; tmax = fmaxf(tmax, sv);
                        }
                    } else {
                        LAS const float* bx = BTX + g * 448 + (288 + qi[cb] - 32 * (kt - 1) - 4 * h - 27);
#pragma unroll
                        for (int i = 0; i < 16; ++i) { const float sv = s[cb][i] + bx[27 - ((i & 3) + 8 * (i >> 2))]; s[cb][i] = sv; tmax = fmaxf(tmax, sv); }
                    }
                    tmax = fmaxf(tmax, xor32(tmax, c.lane));
                    const float mnew = fmaxf(mrun[cb], tmax), alpha = __expf(mrun[cb] - mnew);
                    float psum = 0.f;
#pragma unroll
                    for (int i = 0; i < 16; ++i) { const float pv = __expf(s[cb][i] - mnew); s[cb][i] = pv; psum += pv; }
                    lrun[cb] = lrun[cb] * alpha + psum; mrun[cb] = mnew;
#pragma unroll
                    for (int db = 0; db < 2; ++db)
#pragma unroll
                        for (int i = 0; i < 16; ++i) o[db][cb][i] *= alpha;
                    pf[cb][0] = pack_step(s[cb], 0); pf[cb][1] = pack_step(s[cb], 1);
                }
#pragma unroll
                for (int ss = 0; ss < 2; ++ss)
#pragma unroll
                    for (int db = 0; db < 2; ++db) {
                        const bf16x8 vf = *(const LAS bf16x8*)(VT + (db * 32 + r) * AT_VP + kt * 32 + ss * 16 + h * 8);
#pragma unroll
                        for (int cb = 0; cb < 2; ++cb) o[db][cb] = __builtin_amdgcn_mfma_f32_32x32x16_bf16(vf, pf[cb][ss], o[db][cb], 0, 0, 0);
                    }
            }
            const float sink = p.attn_sinks[j * 16 + head];
#pragma unroll
            for (int cb = 0; cb < 2; ++cb) {
                const float ltot = lrun[cb] + xor32(lrun[cb], c.lane);
                const float mf = fmaxf(mrun[cb], sink), e1 = __expf(mrun[cb] - mf), den = ltot * e1 + __expf(sink - mf), sc = e1 / den;
                const bool st = ismeta ? (cb == 0 && r < 16) : true;
                if (st) {
                    const size_t qrow = ismeta ? (size_t)MR + b * NMETA + r : (size_t)b * SEQ + n * 128 + qi[cb];
#pragma unroll
                    for (int db = 0; db < 2; ++db)
#pragma unroll
                        for (int q4 = 0; q4 < 4; ++q4) {
                            u32x2 w; w.x = pk_bf16(o[db][cb][4 * q4] * sc, o[db][cb][4 * q4 + 1] * sc); w.y = pk_bf16(o[db][cb][4 * q4 + 2] * sc, o[db][cb][4 * q4 + 3] * sc);
                            *(u32x2*)(O + qrow * 1024 + head * 64 + db * 32 + 8 * q4 + 4 * h) = w;
                        }
                }
            }
        }
    }
    __syncthreads();
}
constexpr int LN_AP = 1032;
constexpr int LN_AHI = 0, LN_ALO = 32 * LN_AP * 2;
constexpr int LN_PART = 0;
constexpr int LN_SC = 133120;
constexpr int LN_CH = LN_SC + 32 * 65 * 4;
constexpr int LN_HIST = LN_CH + 32 * 65 * 4;
static_assert(LN_ALO + 32 * LN_AP * 2 <= LN_SC && LN_HIST + 256 <= LDS_BYTES, "LN LDS map");
DI void phase_lnr(const Ctx& c, int layer) {
    const Params p = load_params(c.kp); char* ws = p.ws;
    const bf16_t* V = (const bf16_t*)(ws + WS_V); float* STAT = (float*)(ws + WS_STAT); bf16_t* HB = (bf16_t*)(ws + WS_HB);
    const float* gain = p.ln_gain + (layer * 2 + 0) * 1024; const float* bias = p.ln_bias + (layer * 2 + 0) * 1024;
    const bf16_t* WRH = (const bf16_t*)(ws + WS_WRH) + (size_t)layer * 64 * 1024; const bf16_t* WRL = (const bf16_t*)(ws + WS_WRL) + (size_t)layer * 64 * 1024;
    const float* rbias = p.router_bias + layer * 64;
    int* IDX = (int*)(ws + WS_IDX); float* WT = (float*)(ws + WS_WT); int* HIST = (int*)(ws + WS_HIST);
    LAS bf16_t* AHI = (LAS bf16_t*)(c.lds + LN_AHI); LAS bf16_t* ALO = (LAS bf16_t*)(c.lds + LN_ALO);
    LAS float* PART = (LAS float*)(c.lds + LN_PART); LAS float* SC = (LAS float*)(c.lds + LN_SC); LAS float* CH = (LAS float*)(c.lds + LN_CH); LAS int* hist = (LAS int*)(c.lds + LN_HIST);
    const int lane = c.lane, r = lane & 31, h = lane >> 5;
    if (c.tid < 64) hist[c.tid] = 0;
    const float rb = rbias[lane]; int myhist = 0;
    const int nt = c.wid & 1, kq = c.wid >> 1;
    bf16x8 bhf[16], blf[16];
    {
        const bf16_t* bh = WRH + (size_t)(nt * 32 + r) * 1024 + kq * 256 + h * 8; const bf16_t* bl = WRL + (size_t)(nt * 32 + r) * 1024 + kq * 256 + h * 8;
#pragma unroll
        for (int ks = 0; ks < 16; ++ks) { bhf[ks] = *(const bf16x8*)(bh + ks * 16); blf[ks] = *(const bf16x8*)(bl + ks * 16); }
    }
    const int nreg = (NLN_TILES - c.blk + c.G - 1) / c.G, ntl = nreg + (c.blk < 2 ? 1 : 0);
#define LN_TILE(IT, RB, WST, NR4) do { const bool _p = (IT) >= nreg; RB = _p ? MR + 16 * c.blk : (c.blk + (IT) * c.G) * 32; WST = _p ? 2 : 4; NR4 = _p ? 2 : 4; } while (0)
    u32x2 raw[4][4];
#define LN_FETCH(RB, WST, NR4) do { _Pragma("unroll") for (int r4 = 0; r4 < 4; ++r4) if (r4 < (NR4)) { _Pragma("unroll") for (int jj = 0; jj < 4; ++jj) \
        raw[r4][jj] = *(const u32x2*)(V + ((size_t)(RB) + c.wid * (WST) + r4) * 1024 + jj * 256 + lane * 4); } } while (0)
#define LN_SYNC() do { asm volatile("s_waitcnt lgkmcnt(0)" ::: "memory"); __builtin_amdgcn_s_barrier(); asm volatile("" ::: "memory"); } while (0)
    { int rb0, ws0, n0; LN_TILE(0, rb0, ws0, n0); LN_FETCH(rb0, ws0, n0); }
    f32x4 gv[4], bv[4];
#pragma unroll
    for (int jj = 0; jj < 4; ++jj) { gv[jj] = *(const f32x4*)(gain + jj * 256 + lane * 4); bv[jj] = *(const f32x4*)(bias + jj * 256 + lane * 4); }
#pragma unroll 1
    for (int it = 0; it < ntl; ++it) {
        int rbase, wst, nr4; LN_TILE(it, rbase, wst, nr4);
        LN_SYNC();
#pragma unroll
        for (int r4 = 0; r4 < 4; ++r4) if (r4 < nr4) {
            const int lrow = c.wid * 4 + r4; const size_t row = (size_t)rbase + c.wid * wst + r4;
            f32x4 v[4];
            float s = 0.f;
#pragma unroll
            for (int jj = 0; jj < 4; ++jj) { const u32x2 w = raw[r4][jj]; v[jj] = (f32x4){bflo(w.x), bfhi(w.x), bflo(w.y), bfhi(w.y)}; s += v[jj][0] + v[jj][1] + v[jj][2] + v[jj][3]; }
            const float mu = wave_sum(s) * (1.0f / 1024.0f);
            float q = 0.f;
#pragma unroll
            for (int jj = 0; jj < 4; ++jj) { v[jj] = v[jj] - mu; q += v[jj][0] * v[jj][0] + v[jj][1] * v[jj][1] + v[jj][2] * v[jj][2] + v[jj][3] * v[jj][3]; }
            const float rstd = 1.0f / __builtin_sqrtf(wave_sum(q) * (1.0f / 1024.0f) + LN_EPS);
            if (lane == 0) *(f32x2*)(STAT + row * 2) = (f32x2){mu, rstd};
#pragma unroll
            for (int jj = 0; jj < 4; ++jj) {
                const f32x4 y = v[jj] * rstd * gv[jj] + bv[jj];
                const int col = jj * 256 + lane * 4;
                u32x2 hi; hi.x = pk_bf16(y[0], y[1]); hi.y = pk_bf16(y[2], y[3]);
                *(u32x2*)(HB + row * 1024 + col) = hi;
                u32x2 lo; lo.x = pk_bf16(y[0] - bflo(hi.x), y[1] - bfhi(hi.x)); lo.y = pk_bf16(y[2] - bflo(hi.y), y[3] - bfhi(hi.y));
                *(LAS u32x2*)(AHI + lrow * LN_AP + col) = hi; *(LAS u32x2*)(ALO + lrow * LN_AP + col) = lo;
            }
        }
        if (it + 1 < ntl) { int rb1, ws1, n1; LN_TILE(it + 1, rb1, ws1, n1); LN_FETCH(rb1, ws1, n1); }
        LN_SYNC();
        {
            f32x16 acc;
#pragma unroll
            for (int i = 0; i < 16; ++i) acc[i] = 0.f;
            LAS const bf16_t* ah = AHI + r * LN_AP + kq * 256 + h * 8; LAS const bf16_t* al = ALO + r * LN_AP + kq * 256 + h * 8;
#pragma unroll
            for (int ks = 0; ks < 16; ++ks) {
                const bf16x8 a1 = *(const LAS bf16x8*)(ah + ks * 16), a2 = *(const LAS bf16x8*)(al + ks * 16);
                acc = __builtin_amdgcn_mfma_f32_32x32x16_bf16(a1, bhf[ks], acc, 0, 0, 0);
                acc = __builtin_amdgcn_mfma_f32_32x32x16_bf16(a1, blf[ks], acc, 0, 0, 0);
                acc = __builtin_amdgcn_mfma_f32_32x32x16_bf16(a2, bhf[ks], acc, 0, 0, 0);
            }
            LN_SYNC();
#pragma unroll
            for (int i = 0; i < 16; ++i) PART[(kq * 32 + crow(i, h)) * 65 + nt * 32 + r] = acc[i];
        }
        LN_SYNC();
#pragma unroll 1
        for (int rr = 0; rr < nr4; ++rr) {
            const int t = c.wid * 4 + rr; const size_t grow = (size_t)rbase + c.wid * wst + rr;
            const float lg = PART[(0 * 32 + t) * 65 + lane] + PART[(1 * 32 + t) * 65 + lane] + PART[(2 * 32 + t) * 65 + lane] + PART[(3 * 32 + t) * 65 + lane];
            const float sc = sigmoidf_(lg), ch = sc + rb;
            float v = ch; int vi = lane;
#define LN_STEP(F) { const float ov = __builtin_bit_cast(float, F(__builtin_bit_cast(int, v))); const int oi = F(vi); if (ov > v || (ov == v && oi < vi)) { v = ov; vi = oi; } }
            LN_STEP(dpp_x1) LN_STEP(dpp_x2) LN_STEP(dpp_hm)
#undef LN_STEP
            float v2 = (lane == vi) ? -INFINITY : ch;
            v2 = fmaxf(v2, __builtin_bit_cast(float, dpp_x1(__builtin_bit_cast(int, v2)))); v2 = fmaxf(v2, __builtin_bit_cast(float, dpp_x2(__builtin_bit_cast(int, v2)))); v2 = fmaxf(v2, __builtin_bit_cast(float, dpp_hm(__builtin_bit_cast(int, v2))));
            const float gs = v + v2; const int g = lane >> 3;
            int gcnt = 0;
#pragma unroll
            for (int g2 = 0; g2 < 8; ++g2) { const float gv = __builtin_bit_cast(float, __builtin_amdgcn_readlane(__builtin_bit_cast(int, gs), g2 * 8)); gcnt += ((gv > gs) || (gv == gs && g2 < g)) ? 1 : 0; }
            const float cv = (gcnt < 4) ? ch : -INFINITY;
            int rank = 0;
            const int cbits = __builtin_bit_cast(int, cv); const int ckey = (cbits >= 0 ? cbits : (int)(0x80000000u - (unsigned)cbits)) & ~63 | (63 - lane);
            {
                const unsigned long long bal = __ballot(gcnt < 4);
                unsigned gm = 0;
#pragma unroll
                for (int g2 = 0; g2 < 8; ++g2) gm |= (unsigned)((bal >> (8 * g2)) & 1ull) << g2;
#pragma unroll 1
                while (gm) { const int gsel = __builtin_ctz(gm); gm &= gm - 1u;
#pragma unroll
                    for (int jj = 0; jj < 8; ++jj) { const int k = 8 * gsel + jj; const int kk2 = __builtin_amdgcn_readlane(ckey, k); rank += (kk2 > ckey) ? 1 : 0; } }
            }
            const bool chosen = (gcnt < 4) && (rank < 8);
            const float wsum = wave_sum(chosen ? sc : 0.f);
            if (chosen) { IDX[grow * 8 + rank] = lane; WT[grow * 8 + rank] = sc * (2.5f * __builtin_amdgcn_rcpf(wsum + 1e-20f)); myhist += 1; }
        }
    }
    __syncthreads();
    __hip_atomic_fetch_add(&hist[lane], myhist, __ATOMIC_RELAXED, __HIP_MEMORY_SCOPE_WORKGROUP);
    __syncthreads();
    if (c.tid < 64) HIST[c.blk * 64 + c.tid] = hist[c.tid];
}
DI void phase_scatter(const Ctx& c) {
    char* ws = GPTR(char*, c.kp[23]);
    const int* IDX = (const int*)(ws + WS_IDX); const float* WT = (const float*)(ws + WS_WT); const int* HIST = (const int*)(ws + WS_HIST);
    int* INV = (int*)(ws + WS_INV); int* ROWTOK = (int*)(ws + WS_ROWTOK); float* ROWW = (float*)(ws + WS_ROWW); int* TSTART = (int*)(ws + WS_TSTART);
    LAS int* cnt = (LAS int*)(c.lds); LAS int* pre = cnt + 64; LAS int* pst = pre + 64; LAS int* tst = pst + 80; LAS int* cursor = tst + 80;
    __syncthreads();
    {
        LAS int* ps = cursor + 64;
        const int e = c.tid & 63, part = c.tid >> 6, per = (c.G + 7) >> 3;
        int s0 = 0, m0 = 0;
        for (int b = part * per; b < (part + 1) * per && b < c.G; ++b) { const int v = HIST[b * 64 + e]; s0 += v; if (b < c.blk) m0 += v; }
        ps[part * 64 + e] = s0; ps[512 + part * 64 + e] = m0;
        __syncthreads();
        if (c.tid < 64) { int s1 = 0, m1 = 0;
#pragma unroll
            for (int q = 0; q < 8; ++q) { s1 += ps[q * 64 + c.tid]; m1 += ps[512 + q * 64 + c.tid]; }
            cnt[c.tid] = s1; pre[c.tid] = m1; cursor[c.tid] = 0; }
    }
    __syncthreads();
    if (c.tid == 0) { int ps = 0, ts = 0; for (int e = 0; e < 64; ++e) { pst[e] = ps; tst[e] = ts; const int pad = (cnt[e] + 255) & ~255; ps += pad; ts += pad >> 8; } pst[64] = ps; tst[64] = ts; }
    __syncthreads();
    if (c.blk == 0 && c.tid <= 64) TSTART[c.tid] = tst[c.tid];
    for (int e = c.blk; e < 64; e += c.G) { const int start = pst[e] + cnt[e], end = pst[e + 1]; for (int i = start + c.tid; i < end; i += 512) { ROWTOK[i] = ZROW; ROWW[i] = 0.f; } }
    const int nreg = (NLN_TILES - c.blk + c.G - 1) / c.G, ntl = nreg + (c.blk < 2 ? 1 : 0);
    for (int it = 0; it < ntl; ++it) {
        const bool part = it >= nreg; const size_t a0 = part ? (size_t)(MR + 16 * c.blk) * 8 : (size_t)(c.blk + it * c.G) * 256; const int na = part ? 128 : 256;
        if (c.tid < na) { const size_t a = a0 + c.tid; const int e = IDX[a]; const float w = WT[a];
            const int pos = pst[e] + pre[e] + __hip_atomic_fetch_add(&cursor[e], 1, __ATOMIC_RELAXED, __HIP_MEMORY_SCOPE_WORKGROUP);
            ROWTOK[pos] = (int)(a >> 3); ROWW[pos] = w; INV[a] = pos; }
    }
    __syncthreads();
}
DI int build_tile_table(const Ctx& c, LAS int*& tile_e) {
    const int* TSTART = (const int*)(GPTR(char*, c.kp[23]) + WS_TSTART);
    LAS int* tst = (LAS int*)(c.lds + LDS_MISC); tile_e = tst + 80;
    __syncthreads();
    if (c.tid <= 64) tst[c.tid] = TSTART[c.tid];
    __syncthreads();
    const int nrt = __builtin_amdgcn_readfirstlane(tst[64]);
    for (int t = c.tid; t < nrt; t += 512) { int e = 0;
#pragma unroll
        for (int st = 32; st > 0; st >>= 1) e += (tst[e + st] <= t) ? st : 0;
        tile_e[t] = e; }
    __syncthreads();
    return nrt;
}
DI void phase_egu(const Ctx& c, int layer) {
    char* ws = GPTR(char*, c.kp[23]);
    LAS int* tile_e; const int nrt = build_tile_table(c, tile_e);
    ExpertSched<false> S; S.c = c.blk; S.nrt = nrt; S.tile_e = tile_e; S.ws = ws;
    S.Wr = ws + WS_WEGU + (size_t)layer * 64 * 512 * 1024 * 2; S.Ws = ws + WS_WSGU + (size_t)layer * 512 * 1024 * 2;
    EpiGu E{(bf16_t*)(ws + WS_ACT), (const float*)(ws + WS_ROWW)};
    pg8::gemm_phase(c.lds, c.tid, 1024, 2048u, S, E);
    if (c.tid == 0) {
        __builtin_amdgcn_fence(__ATOMIC_RELEASE, "agent");
        asm volatile("s_waitcnt vmcnt(0)" ::: "memory");
        unsigned* flags = (unsigned*)(ws + WS_CTL + CTL_FLAGS) + layer * 1280;
        const int x = c.blk & 7, sI = c.blk >> 3, ntl = nrt + N_SH_TILES;
        for (int i = 0;; ++i) { const int tile = i * 128 + x * 16 + (sI >> 1); if (tile >= ntl) break;
            (void)__hip_atomic_fetch_add(flags + (tile < nrt ? tile : (SH_BASE >> 8) + (tile - nrt)), 1u, __ATOMIC_RELAXED, __HIP_MEMORY_SCOPE_AGENT); }
    }
}
#define GAS __attribute__((address_space(1)))
DI void phase_edown3(const Ctx& c, int layer) {
    char* ws = GPTR(char*, c.kp[23]);
    LAS int* tile_e; const int nrt = build_tile_table(c, tile_e);
    const int ntiles = nrt + N_SH_TILES;
    const GAS bf16_t* ACT = (const GAS bf16_t*)(ws + WS_ACT); GAS unsigned char* Y8 = (GAS unsigned char*)(ws + WS_U);
    GAS unsigned* flags = (GAS unsigned*)(ws + WS_CTL + CTL_FLAGS) + layer * 1280;
    unsigned fv = 0u;
    const int lane = c.lane, fr = lane & 15, fq = lane >> 4, wid = c.wid;
    unsigned goff[2];
#pragma unroll
    for (int i = 0; i < 2; ++i) { const int p = c.tid + 512 * i, n = p >> 5, kc = (p & 31) ^ (n & 15); goff[i] = (unsigned)(pg8::perm32(n) * 512 + kc * 16); }
    const unsigned ldsw = (unsigned)wid * 1024u;
    LAS unsigned char* ob = c.lds + 65536 + wid * (32 * 160);
#pragma unroll 1
    for (int k = 0;; ++k) {
        const int p = k * 256 + (7 - (c.blk & 7)) * 32 + (31 - (c.blk >> 3));
        if (p >= ntiles) break;
        int tile;
        if (p < 720) tile = (p / 80) * 128 + 48 + p % 80;
        else { const int q = p - 720; tile = (q < 432) ? (q / 48) * 128 + q % 48 : 1152 + (q - 432); }
        const char* wd; int orow;
        if (tile < nrt) { const int e = __builtin_amdgcn_readfirstlane(tile_e[tile]); orow = tile * 256; wd = ws + WS_WED + ((size_t)layer * 64 + e) * ((size_t)1024 * 256 * 2); }
        else { orow = SH_BASE + (tile - nrt) * 256; wd = ws + WS_WSD + (size_t)layer * 1024 * 256 * 2; }
#define D2_STAGE(slot, J) do { _Pragma("unroll") for (int _h = 0; _h < 2; ++_h) _Pragma("unroll") for (int _i = 0; _i < 2; ++_i) \
        __builtin_amdgcn_global_load_lds((const unsigned*)(wd + (size_t)(2 * (J) + _h) * (32 * 512) + goff[_i]), (LAS unsigned*)(c.lds + (slot) * 32768 + _h * 16384 + ldsw + _i * 8192), 16, 0, 0); } while (0)
        if (wid == 0) {
            unsigned sp = 0u;
            while (fv < 2u) { fv = __hip_atomic_load(flags + (orow >> 8), __ATOMIC_RELAXED, __HIP_MEMORY_SCOPE_AGENT); if (fv >= 2u || ++sp > (1u << 18)) break; __builtin_amdgcn_s_sleep(8); }
            __builtin_amdgcn_fence(__ATOMIC_ACQUIRE, "agent");
            asm volatile("s_waitcnt vmcnt(0)" ::: "memory");
        }
        asm volatile("s_waitcnt lgkmcnt(0)" ::: "memory"); __builtin_amdgcn_s_barrier(); asm volatile("" ::: "memory");
        bf16x8 afr[2][8];
#pragma unroll
        for (int mb = 0; mb < 2; ++mb)
#pragma unroll
            for (int ks = 0; ks < 8; ++ks) afr[mb][ks] = *(const GAS bf16x8*)(ACT + (size_t)(orow + 32 * wid + 16 * mb + fr) * 256 + ks * 32 + fq * 8);
        if (wid == 0) {
            const int pn2 = p + 256; fv = 0u;
            if (pn2 < ntiles) { int tn; if (pn2 < 720) tn = (pn2 / 80) * 128 + 48 + pn2 % 80; else { const int q = pn2 - 720; tn = (q < 432) ? (q / 48) * 128 + q % 48 : 1152 + (q - 432); }
                fv = __hip_atomic_load(flags + (tn < nrt ? tn : (SH_BASE >> 8) + (tn - nrt)), __ATOMIC_RELAXED, __HIP_MEMORY_SCOPE_AGENT); }
        }
        D2_STAGE(0, 0);
        bf16x8 bfr[8][2];
        f32x4 acc[2][2];
#pragma unroll
        for (int mb = 0; mb < 2; ++mb)
#pragma unroll
            for (int nb = 0; nb < 2; ++nb) acc[mb][nb] = (f32x4){0.f, 0.f, 0.f, 0.f};
#define D2_READ(SLOT, H) do { \
        LAS const unsigned char* sb = c.lds + (SLOT) * 32768 + (H) * 16384; \
        _Pragma("unroll") for (int ks = 0; ks < 8; ++ks) _Pragma("unroll") for (int nb = 0; nb < 2; ++nb) bfr[ks][nb] = *(const LAS bf16x8*)(sb + ((16 * nb + fr) * 32 + ((4 * ks + fq) ^ fr)) * 16); } while (0)
#define D2_MMA() do { \
        __builtin_amdgcn_sched_barrier(0); __builtin_amdgcn_s_setprio(1);        \
        _Pragma("unroll") for (int ks = 0; ks < 8; ++ks) _Pragma("unroll") for (int mb = 0; mb < 2; ++mb) _Pragma("unroll") for (int nb = 0; nb < 2; ++nb) \
            acc[mb][nb] = __builtin_amdgcn_mfma_f32_16x16x32_bf16(bfr[ks][nb], afr[mb][ks], acc[mb][nb], 0, 0, 0); \
        __builtin_amdgcn_s_setprio(0); __builtin_amdgcn_sched_barrier(0); } while (0)
#define D2_EPI(H, PAR) do { \
        _Pragma("unroll") for (int mb = 0; mb < 2; ++mb) { \
              \
            const float am = fmaxf(fmaxf(fmaxf(__builtin_fabsf(acc[mb][0][0]), __builtin_fabsf(acc[mb][0][1])), fmaxf(__builtin_fabsf(acc[mb][0][2]), __builtin_fabsf(acc[mb][0][3]))), \
                                   fmaxf(fmaxf(__builtin_fabsf(acc[mb][1][0]), __builtin_fabsf(acc[mb][1][1])), fmaxf(__builtin_fabsf(acc[mb][1][2]), __builtin_fabsf(acc[mb][1][3])))); \
            const unsigned eb = ((__float_as_uint(am * (1.0f / 127.0f)) >> 23) & 0xffu) + 1u;        \
            const float inv = __uint_as_float((254u - eb) << 23); \
            unsigned q0 = 0, q1 = 0; \
            q0 = __builtin_amdgcn_cvt_pk_u8_f32(__builtin_fmaf(acc[mb][0][0], inv, 128.0f), 0, q0); q0 = __builtin_amdgcn_cvt_pk_u8_f32(__builtin_fmaf(acc[mb][0][1], inv, 128.0f), 1, q0); \
            q0 = __builtin_amdgcn_cvt_pk_u8_f32(__builtin_fmaf(acc[mb][0][2], inv, 128.0f), 2, q0); q0 = __builtin_amdgcn_cvt_pk_u8_f32(__builtin_fmaf(acc[mb][0][3], inv, 128.0f), 3, q0); \
            q1 = __builtin_amdgcn_cvt_pk_u8_f32(__builtin_fmaf(acc[mb][1][0], inv, 128.0f), 0, q1); q1 = __builtin_amdgcn_cvt_pk_u8_f32(__builtin_fmaf(acc[mb][1][1], inv, 128.0f), 1, q1); \
            q1 = __builtin_amdgcn_cvt_pk_u8_f32(__builtin_fmaf(acc[mb][1][2], inv, 128.0f), 2, q1); q1 = __builtin_amdgcn_cvt_pk_u8_f32(__builtin_fmaf(acc[mb][1][3], inv, 128.0f), 3, q1); \
            *(LAS u32x2*)(ob + (16 * mb + fr) * 160 + PAR * 64 + (H) * 32 + 8 * fq) = (u32x2){q0, q1}; \
            *(LAS unsigned char*)(ob + (16 * mb + fr) * 160 + 128 + (PAR * 2 + (H)) * 4 + fq) = (unsigned char)eb; \
            acc[mb][0] = (f32x4){0.f, 0.f, 0.f, 0.f}; acc[mb][1] = (f32x4){0.f, 0.f, 0.f, 0.f}; \
        } } while (0)
#define D2_EPI2(H, PAR) do { \
        _Pragma("unroll") for (int mb = 0; mb < 2; ++mb) { \
              \
            const float am = fmaxf(fmaxf(fmaxf(__builtin_fabsf(acc2[mb][0][0]), __builtin_fabsf(acc2[mb][0][1])), fmaxf(__builtin_fabsf(acc2[mb][0][2]), __builtin_fabsf(acc2[mb][0][3]))), \
                                   fmaxf(fmaxf(__builtin_fabsf(acc2[mb][1][0]), __builtin_fabsf(acc2[mb][1][1])), fmaxf(__builtin_fabsf(acc2[mb][1][2]), __builtin_fabsf(acc2[mb][1][3])))); \
            const unsigned eb = ((__float_as_uint(am * (1.0f / 127.0f)) >> 23) & 0xffu) + 1u;        \
            const float inv = __uint_as_float((254u - eb) << 23); \
            unsigned q0 = 0, q1 = 0; \
            q0 = __builtin_amdgcn_cvt_pk_u8_f32(__builtin_fmaf(acc2[mb][0][0], inv, 128.0f), 0, q0); q0 = __builtin_amdgcn_cvt_pk_u8_f32(__builtin_fmaf(acc2[mb][0][1], inv, 128.0f), 1, q0); \
            q0 = __builtin_amdgcn_cvt_pk_u8_f32(__builtin_fmaf(acc2[mb][0][2], inv, 128.0f), 2, q0); q0 = __builtin_amdgcn_cvt_pk_u8_f32(__builtin_fmaf(acc2[mb][0][3], inv, 128.0f), 3, q0); \
            q1 = __builtin_amdgcn_cvt_pk_u8_f32(__builtin_fmaf(acc2[mb][1][0], inv, 128.0f), 0, q1); q1 = __builtin_amdgcn_cvt_pk_u8_f32(__builtin_fmaf(acc2[mb][1][1], inv, 128.0f), 1, q1); \
            q1 = __builtin_amdgcn_cvt_pk_u8_f32(__builtin_fmaf(acc2[mb][1][2], inv, 128.0f), 2, q1); q1 = __builtin_amdgcn_cvt_pk_u8_f32(__builtin_fmaf(acc2[mb][1][3], inv, 128.0f), 3, q1); \
            *(LAS u32x2*)(ob + (16 * mb + fr) * 160 + PAR * 64 + (H) * 32 + 8 * fq) = (u32x2){q0, q1}; \
            *(LAS unsigned char*)(ob + (16 * mb + fr) * 160 + 128 + (PAR * 2 + (H)) * 4 + fq) = (unsigned char)eb; \
        } } while (0)
#define D2_BODY(SLOT, J, NW) do { \
        asm volatile("s_waitcnt vmcnt(%0)" :: "n"(NW) : "memory"); \
        if ((J) == 0) __builtin_amdgcn_s_waitcnt(0x0F70);        \
        __builtin_amdgcn_s_barrier(); \
        if ((J) + 1 < 16) D2_STAGE(1 - (SLOT), (J) + 1); \
        D2_READ(SLOT, 0); D2_MMA(); \
        f32x4 acc2[2][2]; _Pragma("unroll") for (int mb = 0; mb < 2; ++mb) _Pragma("unroll") for (int nb = 0; nb < 2; ++nb) { acc2[mb][nb] = acc[mb][nb]; acc[mb][nb] = (f32x4){0.f, 0.f, 0.f, 0.f}; } \
        D2_READ(SLOT, 1);        \
        D2_EPI2(0, (SLOT)); \
        D2_MMA(); \
        D2_EPI(1, (SLOT)); \
        if ((SLOT) == 1) {      \
            _Pragma("unroll") for (int i = 0; i < 4; ++i) { const int q = lane + 64 * i, rr = q >> 3, c16 = q & 7; \
                const u32x4 w = *(const LAS u32x4*)(ob + rr * 160 + c16 * 16); \
                *(GAS u32x4*)(Y8 + (size_t)(orow + 32 * wid + rr) * Y8P + ((J) >> 1) * 128 + c16 * 16) = w; } \
            if (lane < 32) { const u32x4 w = *(const LAS u32x4*)(ob + lane * 160 + 128); \
                *(GAS u32x4*)(Y8 + (size_t)(orow + 32 * wid + lane) * Y8P + 1024 + ((J) >> 1) * 16) = w; } \
        } } while (0)
        D2_BODY(0, 0, 0); D2_BODY(1, 1, 0);
#pragma unroll 1
        for (int J = 2; J < 16; J += 2) { D2_BODY(0, J, 5); D2_BODY(1, J + 1, 0); }
        asm volatile("" ::: "memory");
#undef D2_BODY
#undef D2_READ
#undef D2_MMA
#undef D2_EPI
#undef D2_EPI2
#undef D2_STAGE
    }
}
DI void phase_cln(const Ctx& c, int layer) {
    const Params p = load_params(c.kp); char* ws = p.ws;
    bf16_t* HLO = (bf16_t*)(ws + WS_H); bf16_t* HB = (bf16_t*)(ws + WS_HB); const unsigned char* Y8 = (const unsigned char*)(ws + WS_U); const int* INV = (const int*)(ws + WS_INV);
    const float* gain = p.ln_gain + (layer * 2 + 1) * 1024; const float* bias = p.ln_bias + (layer * 2 + 1) * 1024;
    const bf16_t* V = (const bf16_t*)(ws + WS_V); const float* STAT = (const float*)(ws + WS_STAT);
    const float* gain1 = p.ln_gain + (layer * 2 + 0) * 1024; const float* bias1 = p.ln_bias + (layer * 2 + 0) * 1024;
    const bool last = layer == 3; const int lane = c.lane, c0 = lane * 8;
    f32x4 gv[4], bv[4], g1[4], b1[4];
#pragma unroll
    for (int s = 0; s < 2; ++s)
#pragma unroll
        for (int q = 0; q < 2; ++q) { gv[s * 2 + q] = *(const f32x4*)(gain + s * 512 + c0 + q * 4); bv[s * 2 + q] = *(const f32x4*)(bias + s * 512 + c0 + q * 4);
            g1[s * 2 + q] = *(const f32x4*)(gain1 + s * 512 + c0 + q * 4) * ALPHA; b1[s * 2 + q] = *(const f32x4*)(bias1 + s * 512 + c0 + q * 4) * ALPHA; }
    const int nrows = last ? MR : NR;
    const int stride = c.G * 8;
    int row0 = c.blk * 8 + c.wid;
    int pA = 0, pB = 0;
    { const int rA = row0 < nrows ? row0 : 0, rB = row0 + stride < nrows ? row0 + stride : 0;
      pA = (lane < 8) ? INV[(size_t)rA * 8 + lane] : (SH_BASE + rA); pB = (lane < 8) ? INV[(size_t)rB * 8 + lane] : (SH_BASE + rB); }
    for (; row0 < nrows; row0 += 2 * stride) {
        const int rows2[2] = {row0, row0 + stride};
        const int myp[2] = {pA, pB};
        { const int nA = row0 + 2 * stride, nB = row0 + 3 * stride; const int rA = nA < nrows ? nA : 0, rB = nB < nrows ? nB : 0;
          pA = (lane < 8) ? INV[(size_t)rA * 8 + lane] : (SH_BASE + rA); pB = (lane < 8) ? INV[(size_t)rB * 8 + lane] : (SH_BASE + rB); }
        f32x4 a[2][4];
#pragma unroll
        for (int t = 0; t < 2; ++t) { const int row = rows2[t] < nrows ? rows2[t] : 0;
            const f32x2 st = *(const f32x2*)(STAT + (size_t)row * 2);
#pragma unroll
            for (int s2 = 0; s2 < 2; ++s2) { const u32x4 w = *(const u32x4*)(V + (size_t)row * 1024 + s2 * 512 + c0);
                a[t][s2 * 2] = ((f32x4){bflo(w.x), bfhi(w.x), bflo(w.y), bfhi(w.y)} - st[0]) * st[1] * g1[s2 * 2] + b1[s2 * 2];
                a[t][s2 * 2 + 1] = ((f32x4){bflo(w.z), bfhi(w.z), bflo(w.w), bfhi(w.w)} - st[0]) * st[1] * g1[s2 * 2 + 1] + b1[s2 * 2 + 1]; } }
        u32x2 yw[2][9][2]; float ysc[2][9][2];
#pragma unroll
        for (int t = 0; t < 2; ++t)
#pragma unroll
            for (int k = 0; k < 9; ++k) { const int pos = __builtin_amdgcn_readlane(myp[t], k); const unsigned char* yr = Y8 + (size_t)pos * Y8P;
#pragma unroll
                for (int s2 = 0; s2 < 2; ++s2) { yw[t][k][s2] = *(const u32x2*)(yr + s2 * 512 + c0); ysc[t][k][s2] = __uint_as_float((unsigned)yr[1024 + s2 * 64 + lane] << 23); } }
#pragma unroll
        for (int t = 0; t < 2; ++t) {
#pragma unroll
            for (int k = 0; k < 9; ++k)
#pragma unroll
                for (int s2 = 0; s2 < 2; ++s2) { const u32x2 w = yw[t][k][s2]; const float sc = ysc[t][k][s2], off = -128.0f * sc;
                    a[t][s2 * 2][0] += (float)(w.x & 0xffu) * sc + off; a[t][s2 * 2][1] += (float)((w.x >> 8) & 0xffu) * sc + off; a[t][s2 * 2][2] += (float)((w.x >> 16) & 0xffu) * sc + off; a[t][s2 * 2][3] += (float)(w.x >> 24) * sc + off;
                    a[t][s2 * 2 + 1][0] += (float)(w.y & 0xffu) * sc + off; a[t][s2 * 2 + 1][1] += (float)((w.y >> 8) & 0xffu) * sc + off; a[t][s2 * 2 + 1][2] += (float)((w.y >> 16) & 0xffu) * sc + off; a[t][s2 * 2 + 1][3] += (float)(w.y >> 24) * sc + off; }
            float sm = 0.f;
#pragma unroll
            for (int i = 0; i < 4; ++i) sm += a[t][i][0] + a[t][i][1] + a[t][i][2] + a[t][i][3];
            const float mu = wave_sum(sm) * (1.0f / 1024.0f);
            float q2 = 0.f;
#pragma unroll
            for (int i = 0; i < 4; ++i) { a[t][i] = a[t][i] - mu; q2 += a[t][i][0] * a[t][i][0] + a[t][i][1] * a[t][i][1] + a[t][i][2] * a[t][i][2] + a[t][i][3] * a[t][i][3]; }
            const float rstd = 1.0f / __builtin_sqrtf(wave_sum(q2) * (1.0f / 1024.0f) + LN_EPS);
            if (rows2[t] < nrows) {
#pragma unroll
                for (int s2 = 0; s2 < 2; ++s2) {
                    const f32x4 y0 = a[t][s2 * 2] * rstd * gv[s2 * 2] + bv[s2 * 2], y1 = a[t][s2 * 2 + 1] * rstd * gv[s2 * 2 + 1] + bv[s2 * 2 + 1];
                    const size_t o = (size_t)rows2[t] * 1024 + s2 * 512 + c0;
                    if (last) { *(f32x4*)(p.out + o) = y0; *(f32x4*)(p.out + o + 4) = y1; }
                    else {
                        u32x4 w; w.x = pk_bf16(y0[0], y0[1]); w.y = pk_bf16(y0[2], y0[3]); w.z = pk_bf16(y1[0], y1[1]); w.w = pk_bf16(y1[2], y1[3]);
                        u32x4 l; l.x = pk_bf16(y0[0] - bflo(w.x), y0[1] - bfhi(w.x)); l.y = pk_bf16(y0[2] - bflo(w.y), y0[3] - bfhi(w.y)); l.z = pk_bf16(y1[0] - bflo(w.z), y1[1] - bfhi(w.z)); l.w = pk_bf16(y1[2] - bflo(w.w), y1[3] - bfhi(w.w));
                        *(u32x4*)(HB + o) = w; *(u32x4*)(HLO + o) = l; }
                }
            }
        }
    }
}

DI Ctx make_ctx(unsigned char* smem) {
    Ctx c; c.kp = (KArgPtr)__builtin_amdgcn_kernarg_segment_ptr(); c.lds = (LAS unsigned char*)smem; c.G = (int)gridDim.x; c.blk = (int)blockIdx.x; c.tid = (int)threadIdx.x; c.wid = __builtin_amdgcn_readfirstlane((int)threadIdx.x >> 6); c.lane = (int)threadIdx.x & 63;
    return c;
}
DI void run_phase(const Ctx& c0, int ph, int arg) {
    Ctx c = c0;
    { int w = c0.wid; asm volatile("" : "+s"(w));
      unsigned z = 0u; asm volatile("" : "+v"(z));
      int t = w * 64 + (int)__builtin_amdgcn_mbcnt_hi(~0u, __builtin_amdgcn_mbcnt_lo(~0u, z)); asm volatile("" : "+v"(t)); c.tid = t; c.lane = t & 63; c.wid = w;
      KArgPtr k = c0.kp; asm volatile("" : "+s"(k)); c.kp = k;
      int b = c0.blk; asm volatile("" : "+s"(b)); c.blk = b; int g = c0.G; asm volatile("" : "+s"(g)); c.G = g; }
    char* ws = GPTR(char*, c.kp[23]);
    switch (ph) {
        case 0: phase_prologue(c); break;
        case 1: phase_win(c, arg); break;
        case 2: phase_conv(c, arg); break;
        case 3: phase_gates(c, arg); break;
        case 4: phase_scan1(c); break;
        case 5: phase_scan2(c); break;
        case 6: phase_outproj(c, (const bf16_t*)(ws + WS_U + U_Z), (const bf16_t*)(ws + WS_WOUT) + (size_t)arg * 1024 * 1024, arg == 0); break;
        case 7: phase_qkv(c, arg); break;
        case 8: phase_attn(c, arg); break;
        case 9: phase_outproj(c, (const bf16_t*)(ws + WS_U + U_OB), (const bf16_t*)(ws + WS_WO) + (size_t)arg * 1024 * 1024, false); break;
        case 10: phase_lnr(c, arg); break;
        case 11: phase_scatter(c); break;
        case 12: phase_egu(c, arg); break;
        case 13: phase_edown3(c, arg); break;
        default: phase_cln(c, arg); break;
    }
}
DI void grid_sync(const Ctx& c0, XcdBarrier b) { KArgPtr k = c0.kp; asm volatile("" : "+s"(k)); b.bar = (unsigned*)((char*)k[23] + WS_CTL); unsigned x = b.x; asm volatile("" : "+s"(x)); b.x = x; int w = c0.wid; asm volatile("" : "+s"(w));
    unsigned z = 0u; asm volatile("" : "+v"(z));
    xcd_barrier(b, w == 0 && __builtin_amdgcn_mbcnt_hi(~0u, __builtin_amdgcn_mbcnt_lo(~0u, z)) == 0u); }
#ifndef PROBE_REP
#define PROBE_REP 0
#endif
#if PROBE_REP
#define RUN(ph, arg) do { int _n = 1 + ((PROBE_REP >> (ph)) & 1); asm volatile("" : "+s"(_n)); _Pragma("unroll 1") for (int _r = 0; _r < _n; ++_r) run_phase(c, ph, arg); grid_sync(c, bar); } while (0)
#else
#define RUN(ph, arg) do { run_phase(c, ph, arg); grid_sync(c, bar); } while (0)
#endif
__global__ void __launch_bounds__(512, 2) fwd_all(Params p) {
    extern __shared__ __attribute__((aligned(16))) unsigned char smem[];
    const Ctx c = make_ctx(smem);
    volatile LAS unsigned* st = (volatile LAS unsigned*)(c.lds + LDS_BYTES - 16);
    if (c.tid == 0) { st[0] = 0u; st[1] = 0u; st[2] = 0u; st[3] = 0u; }
    __syncthreads();
    const XcdBarrier bar = xcd_barrier_post((unsigned*)((char*)c.kp[23] + WS_CTL), st);
    RUN(0, 0);
#pragma unroll 1
    for (int layer = 0; layer < 4; ++layer) {
        const int j = layer >> 1;
        if ((layer & 1) == 0) {
            RUN(1, j); RUN(3, j);
            RUN(5, 0); RUN(6, j);
        } else {
            RUN(7, j); RUN(8, j); RUN(9, j);
        }
        RUN(10, layer); RUN(11, 0); run_phase(c, 12, layer); asm volatile("s_nop 0" ::: "memory");
        RUN(13, layer); RUN(14, layer);
    }
}

#if !MK_ONE_LAUNCH
template <int PH> __global__ void __launch_bounds__(512, 2) k_phase(Params p, int arg) {
    extern __shared__ __attribute__((aligned(16))) unsigned char smem[];
    const Ctx c = make_ctx(smem);
    run_phase(c, PH, arg);
}

template <int PH> static void launch_phase(const Params& p, int arg, int grid, hipStream_t stream) {
    static bool attr = false;
    if (!attr) { if (hipFuncSetAttribute((const void*)k_phase<PH>, hipFuncAttributeMaxDynamicSharedMemorySize, LDS_BYTES) != hipSuccess) fprintf(stderr, "kernel_launch: hipFuncSetAttribute failed (phase %d)\n", PH); attr = true; }
    hipLaunchKernelGGL(k_phase<PH>, dim3(grid), dim3(512), LDS_BYTES, stream, p, arg);
}
#endif

extern "C" void kernel_launch(void* const* d_in, const int* in_sizes, int n_in, void* d_out, int out_size, void* d_ws, size_t ws_size, hipStream_t stream) {
    if (n_in != 22 || ws_size < WS_END || out_size != MR * D) { fprintf(stderr, "kernel_launch: unexpected arguments (n_in %d, out %d, ws %zu, need %zu)\n", n_in, out_size, ws_size, (size_t)WS_END); return; }
    Params p{};
    p.x = (const float*)d_in[0]; p.meta = (const float*)d_in[1]; p.rg_w_in = (const float*)d_in[2]; p.rg_b_in = (const float*)d_in[3]; p.rg_conv_w = (const float*)d_in[4]; p.rg_conv_b = (const float*)d_in[5];
    p.rg_w_gates = (const float*)d_in[6]; p.rg_b_gates = (const float*)d_in[7]; p.rg_a_param = (const float*)d_in[8]; p.rg_w_out = (const float*)d_in[9]; p.attn_w_qkv = (const float*)d_in[10]; p.attn_sinks = (const float*)d_in[11];
    p.attn_w_o = (const float*)d_in[12]; p.rel_table = (const float*)d_in[13]; p.ln_gain = (const float*)d_in[14]; p.ln_bias = (const float*)d_in[15]; p.router_w = (const float*)d_in[16]; p.router_bias = (const float*)d_in[17];
    p.ex_w_gu = (const float*)d_in[18]; p.ex_w_down = (const float*)d_in[19]; p.sh_w_gu = (const float*)d_in[20]; p.sh_w_down = (const float*)d_in[21];
    p.out = (float*)d_out; p.ws = (char*)d_ws;
    const int grid = 256;
    (void)hipMemsetAsync((char*)d_ws + WS_CTL, 0, 65536, stream);
#if MK_ONE_LAUNCH
    static int ok = 0;
    if (!ok) {
        int dev = 0, cus = 0, per_cu = 0;
        if (hipGetDevice(&dev) != hipSuccess || hipDeviceGetAttribute(&cus, hipDeviceAttributeMultiprocessorCount, dev) != hipSuccess) { fprintf(stderr, "kernel_launch: device query failed\n"); return; }
        if (hipFuncSetAttribute((const void*)fwd_all, hipFuncAttributeMaxDynamicSharedMemorySize, LDS_BYTES) != hipSuccess) { fprintf(stderr, "kernel_launch: hipFuncSetAttribute failed\n"); return; }
        if (hipOccupancyMaxActiveBlocksPerMultiprocessor(&per_cu, (const void*)fwd_all, 512, LDS_BYTES) != hipSuccess || per_cu < 1) { fprintf(stderr, "kernel_launch: occupancy query says %d\n", per_cu); return; }
        if (cus * per_cu < grid) { fprintf(stderr, "kernel_launch: %d CUs x %d < %d workgroups: not resident\n", cus, per_cu, grid); return; }
        ok = 1;
    }
    hipLaunchKernelGGL(fwd_all, dim3(grid), dim3(512), LDS_BYTES, stream, p);
#else
    launch_phase<0>(p, 0, grid, stream);
    for (int layer = 0; layer < 4; ++layer) {
        const int j = layer >> 1;
        if ((layer & 1) == 0) {
            launch_phase<1>(p, j, grid, stream); launch_phase<3>(p, j, grid, stream);
            launch_phase<5>(p, 0, grid, stream); launch_phase<6>(p, j, grid, stream);
        } else {
            launch_phase<7>(p, j, grid, stream); launch_phase<8>(p, j, grid, stream); launch_phase<9>(p, j, grid, stream);
        }
        launch_phase<10>(p, layer, grid, stream); launch_phase<11>(p, 0, grid, stream); launch_phase<12>(p, layer, grid, stream); launch_phase<13>(p, layer, grid, stream); launch_phase<14>(p, layer, grid, stream);
    }
#endif
}
```
